# Optimizing an MI355X kernel written in HIP

```python
import math
import jax, jax.numpy as jnp
from jax import lax
import numpy as np

D_MODEL = 1024
BATCH = 32
SEQ = 2048
DEPTH = 1
DEC_BATCH = 4
DEC_SEQ = 8192
PAST_LEN = 128

N_META = 16
RWKV_HEADS = 8
RWKV_HEAD_DIM = 64
RWKV_WIDTH = RWKV_HEADS * RWKV_HEAD_DIM
DIFF_HEADS = 4
DIFF_QK_DIM = 64
DIFF_V_DIM = 2 * DIFF_QK_DIM
DIFF_WIDTH = DIFF_HEADS * DIFF_V_DIM
MIX_WIDTH = RWKV_WIDTH + DIFF_WIDTH
DIFF_QK_WIDTH = DIFF_HEADS * 2 * DIFF_QK_DIM
IN_WIDTH = 3 * RWKV_WIDTH + 2 * DIFF_QK_WIDTH + DIFF_WIDTH
DECAY_LORA = 64
AAA_LORA = 64
GATE_LORA = 160
CONV_WIDTH = 3
ROPE_THETA = 500000.0
ROPE_DIMS = DIFF_QK_DIM // 4
D_FF = -(-8 * D_MODEL // (3 * 256)) * 256
Q_BLOCK = 128
NORM_EPS = 1e-6
GN_EPS = 64e-5
DECAY_SCALE = math.exp(-0.5)

kernel_name = "hymba_rwkv7_diffattn_encoder"


def rms_norm(x, g):
    xf = x.astype(jnp.float32)
    y = xf * lax.rsqrt(jnp.mean(xf * xf, axis=-1, keepdims=True) + NORM_EPS)
    return (y * g.astype(jnp.float32)).astype(x.dtype)


def shift_prev(x):
    return jnp.pad(x, ((0, 0), (1, 0), (0, 0)))[:, :-1]


def shift_next(x):
    return jnp.pad(x, ((0, 0), (0, 1), (0, 0)))[:, 1:]


def centred_conv(x, w):
    return w[0] * shift_prev(x) + w[1] * x + w[2] * shift_next(x)


def wkv7_scan(r, w, k, v, a_, b_, reverse):
    B, T, H, N = r.shape

    def step(S, inp):
        rt, wt, kt, vt, at, bt = inp
        sa = jnp.einsum('bhij,bhj->bhi', S, at)
        S = S * wt[:, :, None, :] + sa[..., None] * bt[:, :, None, :] + vt[..., None] * kt[:, :, None, :]
        return S, jnp.einsum('bhij,bhj->bhi', S, rt)

    xs = tuple(jnp.moveaxis(t, 1, 0) for t in (r, w, k, v, a_, b_))
    S0 = jnp.zeros((B, H, N, N), jnp.float32)
    _, y = lax.scan(step, S0, xs, reverse=reverse)
    return jnp.moveaxis(y, 0, 1)


def rwkv7_mixer(h, r, k, v, p):
    B, T, _ = h.shape
    H, N = RWKV_HEADS, RWKV_HEAD_DIM
    hf = h.astype(jnp.float32)
    r, k, v = (t.astype(jnp.float32) for t in (r, k, v))
    delta = 0.5 * (shift_prev(hf) + shift_next(hf)) - hf
    xg = hf + delta * p['mix_g']
    g = jax.nn.sigmoid(xg @ p['gate_g1']) @ p['gate_g2']
    kk = (k * p['k_k']).reshape(B, T, H, N)
    kk = kk / jnp.maximum(jnp.linalg.norm(kk, axis=-1, keepdims=True), 1e-12)
    rh = r.reshape(B, T, H, N)
    vh = v.reshape(B, T, H, N)
    y_sum = jnp.zeros((B, T, H, N), jnp.float32)
    bonus = jnp.zeros((B, T, H, N), jnp.float32)
    for d in range(2):
        xw = hf + delta * p['mix_w'][d]
        xa = hf + delta * p['mix_a'][d]
        w = jnp.exp(-DECAY_SCALE * jax.nn.sigmoid(p['decay_w0'][d] + jnp.tanh(xw @ p['decay_w1'][d]) @ p['decay_w2'][d]))
        a = jax.nn.sigmoid(p['aaa_a0'][d] + (xa @ p['aaa_a1'][d]) @ p['aaa_a2'][d])
        kd = k * (1.0 + (a - 1.0) * p['k_a'])
        kdh = kd.reshape(B, T, H, N)
        ah = a.reshape(B, T, H, N)
        y_sum = y_sum + wkv7_scan(rh, w.reshape(B, T, H, N), kdh, vh, -kk, kk * ah, reverse=(d == 1))
        bonus = bonus + jnp.sum(rh * kdh * p['r_k'], axis=-1, keepdims=True) * vh
    mu = jnp.mean(y_sum, axis=-1, keepdims=True)
    var = jnp.mean(jnp.square(y_sum - mu), axis=-1, keepdims=True)
    yn = (y_sum - mu) * lax.rsqrt(var + GN_EPS)
    yn = yn * p['lnx_g'].reshape(H, N) + p['lnx_b'].reshape(H, N)
    out = (yn + bonus).reshape(B, T, RWKV_WIDTH) * g
    return out.astype(h.dtype)


def partial_rope(x):
    T = x.shape[1]
    half = ROPE_DIMS // 2
    freqs = ROPE_THETA ** (-jnp.arange(0, ROPE_DIMS, 2, dtype=jnp.float32) / ROPE_DIMS)
    ang = jnp.arange(T, dtype=jnp.float32)[:, None] * freqs[None, :]
    cos = jnp.cos(ang)[None, :, None, None, :]
    sin = jnp.sin(ang)[None, :, None, None, :]
    xf = x.astype(jnp.float32)
    x1, x2, rest = xf[..., :half], xf[..., half:ROPE_DIMS], xf[..., ROPE_DIMS:]
    out = jnp.concatenate([x1 * cos - x2 * sin, x2 * cos + x1 * sin, rest], axis=-1)
    return out.astype(x.dtype)


def diff_attention(q, k, v, p, lambda_init):
    B, T, _ = q.shape
    H, d = DIFF_HEADS, DIFF_QK_DIM
    q = q.reshape(B, T, H, 2, d)
    k = k.reshape(B, T, H, 2, d)
    v = v.reshape(B, T, H, DIFF_V_DIM).astype(jnp.float32)
    q = partial_rope(rms_norm(q, p['q_norm_g'])).astype(jnp.float32) * (d ** -0.5)
    k = partial_rope(rms_norm(k, p['k_norm_g'])).astype(jnp.float32)
    lam_v = p['diff_lambdas'].astype(jnp.float32)
    lam = jnp.exp(jnp.sum(lam_v[0] * lam_v[1])) - jnp.exp(jnp.sum(lam_v[2] * lam_v[3])) + lambda_init

    def attend(qb):
        s = jnp.einsum('bqhcd,bkhcd->bhcqk', qb, k)
        pr = jax.nn.softmax(s, axis=-1)
        amap = pr[:, :, 0] - lam * pr[:, :, 1]
        return jnp.einsum('bhqk,bkhe->bqhe', amap, v)

    meta_out = attend(q[:, :N_META])
    n_blk = (T - N_META) // Q_BLOCK
    qb = q[:, N_META:].reshape(B, n_blk, Q_BLOCK, H, 2, d).transpose(1, 0, 2, 3, 4, 5)
    ob = lax.map(attend, qb)
    real_out = ob.transpose(1, 0, 2, 3, 4).reshape(B, T - N_META, H, DIFF_V_DIM)
    o = jnp.concatenate([meta_out, real_out], axis=1)
    o = rms_norm(o, p['subln_g']) * (1.0 - lambda_init)
    return o.reshape(B, T, DIFF_WIDTH).astype(q.dtype)


def encoder_layer(x, p, lambda_init):
    n = rms_norm(x, p['ln1_g'])
    proj = n @ p['w_in']
    c0 = 3 * RWKV_WIDTH
    rkv = centred_conv(proj[..., :c0], p['conv_rkv'])
    r, k, v = rkv[..., :RWKV_WIDTH], rkv[..., RWKV_WIDTH:2 * RWKV_WIDTH], rkv[..., 2 * RWKV_WIDTH:]
    qd = proj[..., c0:c0 + DIFF_QK_WIDTH]
    kd = proj[..., c0 + DIFF_QK_WIDTH:c0 + 2 * DIFF_QK_WIDTH]
    vd = proj[..., c0 + 2 * DIFF_QK_WIDTH:]
    ya = rwkv7_mixer(n, r, k, v, p)
    yb = diff_attention(qd, kd, vd, p, lambda_init)
    x = x + jnp.concatenate([ya, yb], axis=-1) @ p['w_out']
    n2 = rms_norm(x, p['ln2_g'])
    x = x + (jax.nn.silu(n2 @ p['w_gate']) * (n2 @ p['w_up'])) @ p['w_down']
    return x


def trunk(x, meta_tokens, p):
    B = x.shape[0]
    meta = jnp.broadcast_to(meta_tokens.astype(x.dtype)[None], (B, N_META, D_MODEL))
    h = jnp.concatenate([meta, x], axis=1)
    for l in range(DEPTH):
        pl = {name: arr[l] for name, arr in p.items()}
        lambda_init = 0.8 - 0.6 * math.exp(-0.3 * l)
        h = encoder_layer(h, pl, lambda_init)
    return h[:, N_META:]


def setup_inputs(seed: int = 0) -> dict:
    key = jax.random.key(seed)
    ks = iter(jax.random.split(key, 40))

    def nrm(shape, scale):
        return jax.random.normal(next(ks), shape, jnp.float32) * scale

    L = DEPTH
    conv_c = 1.0 + nrm((L, 1, 3 * RWKV_WIDTH), 0.05)
    conv_s = nrm((L, 2, 3 * RWKV_WIDTH), 0.1)
    conv_rkv = jnp.concatenate([conv_s[:, :1], conv_c, conv_s[:, 1:]], axis=1)
    return {
        'x_prompt': nrm((BATCH, SEQ, D_MODEL), 1.0),
        'x_sample': nrm((DEC_BATCH, DEC_SEQ, D_MODEL), 1.0),
        'meta_tokens': nrm((N_META, D_MODEL), 1.0),
        'ln1_g': 1.0 + nrm((L, D_MODEL), 0.05),
        'w_in': nrm((L, D_MODEL, IN_WIDTH), D_MODEL ** -0.5),
        'conv_rkv': conv_rkv,
        'mix_w': jax.random.uniform(next(ks), (L, 2, D_MODEL), jnp.float32),
        'mix_a': jax.random.uniform(next(ks), (L, 2, D_MODEL), jnp.float32),
        'mix_g': jax.random.uniform(next(ks), (L, D_MODEL), jnp.float32),
        'decay_w0': -1.0 + nrm((L, 2, RWKV_WIDTH), 0.5),
        'decay_w1': nrm((L, 2, D_MODEL, DECAY_LORA), D_MODEL ** -0.5),
        'decay_w2': nrm((L, 2, DECAY_LORA, RWKV_WIDTH), 0.1 * DECAY_LORA ** -0.5),
        'aaa_a0': nrm((L, 2, RWKV_WIDTH), 0.1),
        'aaa_a1': nrm((L, 2, D_MODEL, AAA_LORA), D_MODEL ** -0.5),
        'aaa_a2': nrm((L, 2, AAA_LORA, RWKV_WIDTH), 0.1 * AAA_LORA ** -0.5),
        'gate_g1': nrm((L, D_MODEL, GATE_LORA), D_MODEL ** -0.5),
        'gate_g2': nrm((L, GATE_LORA, RWKV_WIDTH), GATE_LORA ** -0.5),
        'k_k': 0.85 + nrm((L, RWKV_WIDTH), 0.05),
        'k_a': 1.0 + nrm((L, RWKV_WIDTH), 0.05),
        'r_k': nrm((L, RWKV_HEADS, RWKV_HEAD_DIM), 0.1),
        'lnx_g': 1.0 + nrm((L, RWKV_WIDTH), 0.05),
        'lnx_b': nrm((L, RWKV_WIDTH), 0.01),
        'q_norm_g': 1.0 + nrm((L, DIFF_QK_DIM), 0.05),
        'k_norm_g': 1.0 + nrm((L, DIFF_QK_DIM), 0.05),
        'diff_lambdas': nrm((L, 4, DIFF_QK_DIM), 0.1),
        'subln_g': 1.0 + nrm((L, DIFF_V_DIM), 0.05),
        'w_out': nrm((L, MIX_WIDTH, D_MODEL), MIX_WIDTH ** -0.5),
        'ln2_g': 1.0 + nrm((L, D_MODEL), 0.05),
        'w_gate': nrm((L, D_MODEL, D_FF), D_MODEL ** -0.5),
        'w_up': nrm((L, D_MODEL, D_FF), D_MODEL ** -0.5),
        'w_down': nrm((L, D_FF, D_MODEL), D_FF ** -0.5),
    }


def reference(x_prompt, x_sample, meta_tokens, ln1_g, w_in, conv_rkv, mix_w, mix_a, mix_g,
              decay_w0, decay_w1, decay_w2, aaa_a0, aaa_a1, aaa_a2, gate_g1, gate_g2,
              k_k, k_a, r_k, lnx_g, lnx_b, q_norm_g, k_norm_g, diff_lambdas, subln_g,
              w_out, ln2_g, w_gate, w_up, w_down):
    p = {
        'ln1_g': ln1_g, 'w_in': w_in, 'conv_rkv': conv_rkv,
        'mix_w': mix_w, 'mix_a': mix_a, 'mix_g': mix_g,
        'decay_w0': decay_w0, 'decay_w1': decay_w1, 'decay_w2': decay_w2,
        'aaa_a0': aaa_a0, 'aaa_a1': aaa_a1, 'aaa_a2': aaa_a2,
        'gate_g1': gate_g1, 'gate_g2': gate_g2,
        'k_k': k_k, 'k_a': k_a, 'r_k': r_k, 'lnx_g': lnx_g, 'lnx_b': lnx_b,
        'q_norm_g': q_norm_g, 'k_norm_g': k_norm_g, 'diff_lambdas': diff_lambdas,
        'subln_g': subln_g, 'w_out': w_out, 'ln2_g': ln2_g,
        'w_gate': w_gate, 'w_up': w_up, 'w_down': w_down,
    }
    y_prompt = trunk(x_prompt, meta_tokens, p)
    y_sample = trunk(x_sample, meta_tokens, p)
    return (y_prompt, y_sample)
```

```cpp
#include <hip/hip_runtime.h>
#include <hip/hip_cooperative_groups.h>
#include <cstdio>
#include <cstdint>
namespace cg = cooperative_groups;

typedef unsigned short bf16_t;
typedef short bf16x8 __attribute__((ext_vector_type(8)));
typedef short s16x4 __attribute__((ext_vector_type(4)));
typedef float f32x4 __attribute__((ext_vector_type(4)));
typedef float f32x16 __attribute__((ext_vector_type(16)));
typedef unsigned u32x4 __attribute__((ext_vector_type(4)));
typedef unsigned u32x2 __attribute__((ext_vector_type(2)));
typedef _Float16 f16x8 __attribute__((ext_vector_type(8)));
#define LAS __attribute__((address_space(3)))
#define DBG_DROP 0
#define NREP_GEMM 1
#define NREP_SCAN 1
#define NREP_ELT 1

constexpr int DM = 1024, TP = 2064, TS = 8208, BP = 32, BS = 4, SP = 2048, SS = 8192;
constexpr int MP = BP * TP, MS = BS * TS, MF = MP + MS;
constexpr int CP = BP * SP, CS = BS * SS, MC = CP + CS;
constexpr int DFF = 2816, NGU = 2 * DFF;
constexpr int LDQ = 1536;

constexpr size_t al256(size_t x) { return (x + 255) / 256 * 256; }
constexpr size_t WS_WIN = 0;
constexpr size_t WS_W2 = WS_WIN + (size_t)4096 * 1024 * 2;
constexpr size_t WS_WOUT = WS_W2 + (size_t)2560 * 512 * 2;
constexpr size_t WS_WGU = WS_WOUT + (size_t)1024 * 1024 * 2;
constexpr size_t WS_WDN = WS_WGU + (size_t)NGU * 1024 * 2;
constexpr size_t WS_MISC = WS_WDN + (size_t)1024 * DFF * 2;
constexpr size_t WS_R1 = WS_MISC + 4096;
constexpr size_t WS_R2 = WS_R1 + (size_t)MF * 1536 * 2;
constexpr size_t WS_R3 = WS_R2 + (size_t)MF * 2048 * 2;
constexpr size_t WS_R4 = WS_R3 + (size_t)MF * 1024 * 2;
constexpr size_t WS_BON = WS_R4 + (size_t)MF * 512 * 2;
constexpr size_t WS_SSQ = WS_BON + (size_t)2 * MC * 8 * 4;
constexpr size_t WS_BAR = al256(WS_SSQ + (size_t)MC * 4);
constexpr size_t WS_ROPE = WS_BAR + 16384;
constexpr size_t WS_END = WS_ROPE + (size_t)TS * 16 * 4 + 65536;

struct Params {
  const float* in[31];
  float* out;
  unsigned char* ws;
};

__device__ __forceinline__ unsigned cvt_pk_bf16(float lo, float hi) { unsigned r; asm volatile("v_cvt_pk_bf16_f32 %0, %1, %2" : "=v"(r) : "v"(lo), "v"(hi)); return r; }
__device__ __forceinline__ bf16_t f2bf(float f) { return (bf16_t)(cvt_pk_bf16(f, 0.f) & 0xffffu); }
__device__ __forceinline__ float bf2f(bf16_t b) { return __uint_as_float(((unsigned)b) << 16); }
__device__ __forceinline__ float bflo(unsigned w) { return __uint_as_float(w << 16); }
__device__ __forceinline__ float bfhi(unsigned w) { return __uint_as_float(w & 0xffff0000u); }
__device__ __forceinline__ int tid_() { int t = threadIdx.x; asm volatile("" : "+v"(t)); return t; }
__device__ __forceinline__ float sigmoidf_(float x) { return __builtin_amdgcn_rcpf(1.0f + __expf(-x)); }
template <int CTRL> __device__ __forceinline__ float dppf(float x) { return __int_as_float(__builtin_amdgcn_update_dpp(0, __float_as_int(x), CTRL, 0xF, 0xF, true)); }
#ifndef USE_SHFL
#define USE_SHFL 0
#endif
#if USE_SHFL
__device__ __forceinline__ float quad_sum(float x) { x += __shfl_xor(x, 1); x += __shfl_xor(x, 2); return x; }
__device__ __forceinline__ float oct_sum(float x) { x = quad_sum(x); x += __shfl_xor(x, 4); return x; }
__device__ __forceinline__ float row16_sum(float x) { x = oct_sum(x); x += __shfl_xor(x, 8); return x; }
__device__ __forceinline__ float half32_sum(float x) { x = row16_sum(x); x += __shfl_xor(x, 16); return x; }
__device__ __forceinline__ float wave_sum(float x) { x = half32_sum(x); x += __shfl_xor(x, 32); return x; }
#else
__device__ __forceinline__ float quad_sum(float x) { x += dppf<0xB1>(x); x += dppf<0x4E>(x); return x; }
__device__ __forceinline__ float oct_sum(float x) { x = quad_sum(x); x += dppf<0x141>(x); return x; }
__device__ __forceinline__ float row16_sum(float x) { x = oct_sum(x); x += dppf<0x140>(x); return x; }
__device__ __forceinline__ float half32_sum(float x) { x = row16_sum(x);
  auto r = __builtin_amdgcn_permlane16_swap(__float_as_uint(x), __float_as_uint(x), false, false); return __uint_as_float(r[0]) + __uint_as_float(r[1]); }
__device__ __forceinline__ float wave_sum(float x) { x = half32_sum(x);
  auto r = __builtin_amdgcn_permlane32_swap(__float_as_uint(x), __float_as_uint(x), false, false); return __uint_as_float(r[0]) + __uint_as_float(r[1]); }
#endif

__device__ __forceinline__ int compact_to_full(int c) { if (c < CP) return (c >> 11) * TP + 16 + (c & 2047); const int cc = c - CP; return MP + (cc >> 13) * TS + 16 + (cc & 8191); }
__device__ __forceinline__ void full_decode(int r, int& T, int& t, int& seq0, int& cseq0) {
  if (r < MP) { const int b = r / TP; t = r - b * TP; T = TP; seq0 = b * TP; cseq0 = b * SP; }
  else { const int rr = r - MP; const int b = rr / TS; t = rr - b * TS; T = TS; seq0 = MP + b * TS; cseq0 = CP + b * SS; } }

namespace pg8 {
constexpr int BM = 256, BK = 64, HALF = 128, HTB = HALF * BK * 2, STAGE_BYTES = 8 * HTB, NXCD = 8, WGM = 8;
__host__ __device__ __forceinline__ int lds_byte(int r, int c) { const int st = (r >> 4) * 2 + (c >> 5), rr = r & 15, cc = c & 31, ob = rr * 64 + cc * 2; return st * 1024 + (ob ^ (((ob >> 9) & 1) << 5)); }
__host__ __device__ __forceinline__ void stage_rc(int b, int& R, int& C) { const int st = b / 1024, sb = b % 1024, swz = sb ^ (((sb >> 9) & 1) << 5); R = (st >> 1) * 16 + swz / 64; C = (st & 1) * 32 + (swz % 64) / 2; }
__host__ __device__ __forceinline__ int perm32(int rho) { const int n = rho >> 4, i = rho & 15; return 8 * (i >> 2) + 4 * n + (i & 3); }
struct Unit { int pm, pn; };
struct Gemm { const bf16_t* A; const bf16_t* Bt; int lda; int K; };
struct StaticOrder {
  int nM, nN, nwg, G, c, compactA;
  __device__ void init(int nM_, int nN_, int G_, int c_, int compactA_) { nM = nM_; nN = nN_; nwg = nM * nN; G = G_; c = c_; compactA = compactA_; }
  __device__ bool next(int i, Unit& u) const {
    const long L = (long)i * G + c; if (L >= nwg) return false;
    int wgid = (int)L; { const int q = nwg / NXCD, r = nwg % NXCD, xcd = wgid % NXCD, off = wgid / NXCD; wgid = (xcd < r ? xcd * (q + 1) : r * (q + 1) + (xcd - r) * q) + off; }
    const int nig = WGM * nN, gid = wgid / nig, fm = gid * WGM, gsz = (nM - fm) < WGM ? (nM - fm) : WGM;
    u.pm = fm + ((wgid % nig) % gsz); u.pn = (wgid % nig) / gsz; return true;
  }
  __device__ __forceinline__ size_t arow(int pm) const { return compactA ? (size_t)compact_to_full(pm * BM) : (size_t)pm * BM; }
};

template <class Epi>
__device__ __forceinline__ void gemm_phase(LAS unsigned char* lds, const Gemm g, const StaticOrder& S, const Epi& E) {
  const int tid = tid_(), wid = __builtin_amdgcn_readfirstlane(tid >> 6), lane = tid & 63, wr = wid >> 2, wc = wid & 3, fr = lane & 15, fq = lane >> 4;
  int K = g.K; if (Epi::LAUNDER_K) asm volatile("" : "+s"(K)); const int nt = K / BK, lda = g.lda;
  unsigned voffA[2], voffB[2];
#pragma unroll
  for (int i = 0; i < 2; ++i) { int R, C; stage_rc(tid * 16 + i * 8192, R, C); const int Rb = Epi::PERM ? ((R & ~31) + perm32(R & 31)) : R;
    voffA[i] = (unsigned)(R * lda + C) * 2u; voffB[i] = (unsigned)(Rb * K + C) * 2u; }
  const size_t kstep = (size_t)(BK * 2);
  const size_t hstepA = (size_t)HALF * lda * 2, hstepB = (size_t)HALF * K * 2;
  const size_t tstepB = 2 * hstepB;
  const unsigned ldsw = (unsigned)wid * 1024u;
  const int aoff = lds_byte(wr * 64 + fr, fq * 8), boff = lds_byte(wc * 32 + fr, fq * 8);
#define PG8_SA(b, h) (((b) * 2 + (h)) * HTB)
#define PG8_SB(b, h) ((4 + (b) * 2 + (h)) * HTB)
#define PG8_STAGE(bufoff, gbase, voff) do { _Pragma("unroll") for (int _i = 0; _i < 2; ++_i) \
    __builtin_amdgcn_global_load_lds((const unsigned*)((const char*)(gbase) + (voff)[_i]), (LAS unsigned*)(lds + (bufoff) + ldsw + _i * 8192), 16, 0, 0); } while (0)
#define PG8_LDA(dst, b, h) do { _Pragma("unroll") for (int m = 0; m < 4; ++m) _Pragma("unroll") for (int k = 0; k < 2; ++k) dst[m][k] = *(const LAS bf16x8*)(lds + PG8_SA(b, h) + aoff + m * 2048 + k * 1024); } while (0)
#define PG8_LDB(dst, b, h) do { _Pragma("unroll") for (int n = 0; n < 2; ++n) _Pragma("unroll") for (int k = 0; k < 2; ++k) dst[n][k] = *(const LAS bf16x8*)(lds + PG8_SB(b, h) + boff + n * 2048 + k * 1024); } while (0)
#define PG8_MMA(ai, bj, At, Bt) do { __builtin_amdgcn_s_setprio(1); _Pragma("unroll") for (int m = 0; m < 4; ++m) _Pragma("unroll") for (int n = 0; n < 2; ++n) _Pragma("unroll") for (int k = 0; k < 2; ++k) \
    acc[ai][bj][m][n] = __builtin_amdgcn_mfma_f32_16x16x32_bf16(Bt[n][k], At[m][k], acc[ai][bj][m][n], 0, 0, 0); __builtin_amdgcn_s_setprio(0); } while (0)
#define PG8_WAIT_V(n) asm volatile("s_waitcnt vmcnt(" #n ")" ::: "memory")
#define PG8_WAIT_L(n) asm volatile("s_waitcnt lgkmcnt(" #n ")" ::: "memory")
#define PG8_BAR __builtin_amdgcn_s_barrier()
#define PG8_SCHED __builtin_amdgcn_sched_barrier(0)
  Unit cur, nxt; int ui = 0;
  if (!S.next(0, cur)) return;
  f32x4 acc[2][2][4][2];
#pragma unroll
  for (int a = 0; a < 2; ++a)
#pragma unroll
    for (int b = 0; b < 2; ++b)
#pragma unroll
      for (int m = 0; m < 4; ++m)
#pragma unroll
        for (int n = 0; n < 2; ++n) acc[a][b][m][n] = (f32x4){0.f, 0.f, 0.f, 0.f};
  bf16x8 At[4][2], B0[2][2], B1[2][2];
  const char* cA = (const char*)g.A + S.arow(cur.pm) * (size_t)lda * 2 + Epi::acol(cur.pn) * 2; const char* cB = (const char*)g.Bt + (size_t)cur.pn * tstepB;
  PG8_STAGE(PG8_SB(0, 0), cB, voffB); PG8_STAGE(PG8_SA(0, 0), cA, voffA); PG8_STAGE(PG8_SB(0, 1), cB + hstepB, voffB); PG8_STAGE(PG8_SA(0, 1), cA + hstepA, voffA);
  if (wr == 1) PG8_BAR;
  PG8_WAIT_V(4); PG8_BAR;
  PG8_STAGE(PG8_SB(1, 0), cB + kstep, voffB); PG8_STAGE(PG8_SA(1, 0), cA + kstep, voffA); PG8_STAGE(PG8_SB(1, 1), cB + hstepB + kstep, voffB);
  PG8_WAIT_V(6); PG8_BAR;
  for (;;) {
    const bool has_next = S.next(ui + 1, nxt);
    const char* nA = has_next ? (const char*)g.A + S.arow(nxt.pm) * (size_t)lda * 2 + Epi::acol(nxt.pn) * 2 : cA; const char* nB = has_next ? (const char*)g.Bt + (size_t)nxt.pn * tstepB : cB;
    for (int t = 0; t < nt; t += 2) {
      const bool last = (t == nt - 2);
      const char* a1 = cA + (size_t)(t + 1) * kstep;
      const char* a2 = last ? nA : cA + (size_t)(t + 2) * kstep; const char* b2 = last ? nB : cB + (size_t)(t + 2) * kstep;
      const char* a3 = a2 + kstep; const char* b3 = b2 + kstep;
      PG8_LDB(B0, 0, 0); PG8_SCHED; PG8_LDA(At, 0, 0); PG8_STAGE(PG8_SA(1, 1), a1 + hstepA, voffA);
      PG8_WAIT_L(8); PG8_BAR; PG8_WAIT_L(0); PG8_MMA(0, 0, At, B0); PG8_BAR; PG8_SCHED;
      PG8_LDB(B1, 0, 1); PG8_STAGE(PG8_SB(0, 0), b2, voffB);
      PG8_BAR; PG8_WAIT_L(0); PG8_MMA(0, 1, At, B1); PG8_BAR;
      PG8_LDA(At, 0, 1); PG8_STAGE(PG8_SA(0, 0), a2, voffA);
      PG8_BAR; PG8_WAIT_L(0); PG8_MMA(1, 0, At, B0); PG8_BAR; PG8_SCHED;
      PG8_STAGE(PG8_SB(0, 1), b2 + hstepB, voffB);
      PG8_WAIT_V(6); PG8_BAR; PG8_MMA(1, 1, At, B1); PG8_BAR;
      PG8_LDB(B0, 1, 0); PG8_SCHED; PG8_LDA(At, 1, 0); PG8_STAGE(PG8_SA(0, 1), a2 + hstepA, voffA);
      PG8_WAIT_L(8); PG8_BAR; PG8_WAIT_L(0); PG8_MMA(0, 0, At, B0); PG8_BAR; PG8_SCHED;
      PG8_LDB(B1, 1, 1); PG8_STAGE(PG8_SB(1, 0), b3, voffB);
      PG8_BAR; PG8_WAIT_L(0); PG8_MMA(0, 1, At, B1); PG8_BAR;
      PG8_LDA(At, 1, 1); PG8_STAGE(PG8_SA(1, 0), a3, voffA);
      PG8_BAR; PG8_WAIT_L(0); PG8_MMA(1, 0, At, B0); PG8_BAR; PG8_SCHED;
      PG8_STAGE(PG8_SB(1, 1), b3 + hstepB, voffB);
      PG8_WAIT_V(6); PG8_BAR; PG8_MMA(1, 1, At, B1); PG8_BAR;
    }
    E(acc, cur, wr, wc, fr, fq);
    if (!has_next) break;
#pragma unroll
    for (int a = 0; a < 2; ++a)
#pragma unroll
      for (int b = 0; b < 2; ++b)
#pragma unroll
        for (int m = 0; m < 4; ++m)
#pragma unroll
          for (int n = 0; n < 2; ++n) acc[a][b][m][n] = (f32x4){0.f, 0.f, 0.f, 0.f};
    cur = nxt; cA = nA; cB = nB; ++ui;
  }
  PG8_WAIT_V(0);
  if (wr == 0) PG8_BAR;
  PG8_BAR;
#undef PG8_SA
#undef PG8_SB
#undef PG8_STAGE
#undef PG8_LDA
#undef PG8_LDB
#undef PG8_MMA
#undef PG8_WAIT_V
#undef PG8_WAIT_L
#undef PG8_BAR
#undef PG8_SCHED
}
}
using pg8::Unit;

struct EpiProj {
  static constexpr bool LAUNDER_K = false;
  static __device__ __forceinline__ size_t acol(int) { return 0; }
  static constexpr bool PERM = true;
  bf16_t *rkv, *qkvd, *pq;
  __device__ __forceinline__ void operator()(const f32x4 (&acc)[2][2][4][2], const Unit& u, int wr, int wc, int fr, int fq) const {
    const int row0 = u.pm * 256 + wr * 64 + fr;
    bf16_t* base; int ldc, colt;
    if (u.pn < 6) { base = rkv; ldc = LDQ; colt = u.pn * 256; } else if (u.pn < 12) { base = qkvd; ldc = LDQ; colt = u.pn * 256 - 1536; } else { base = pq; ldc = 1024; colt = u.pn * 256 - 3072; }
    const int col0 = colt + wc * 32 + 8 * fq;
#pragma unroll
    for (int ai = 0; ai < 2; ++ai)
#pragma unroll
      for (int m = 0; m < 4; ++m) { const int row = row0 + ai * 128 + m * 16; if (row < MF) { bf16_t* rowp = base + (size_t)row * ldc + col0;
#pragma unroll
          for (int bj = 0; bj < 2; ++bj) { const f32x4 v0 = acc[ai][bj][m][0], v1 = acc[ai][bj][m][1];
            u32x4 w; w.x = cvt_pk_bf16(v0[0], v0[1]); w.y = cvt_pk_bf16(v0[2], v0[3]); w.z = cvt_pk_bf16(v1[0], v1[1]); w.w = cvt_pk_bf16(v1[2], v1[3]);
            *(u32x4*)(rowp + bj * 128) = w; } } }
  }
};
struct EpiLora2 {
  static constexpr bool LAUNDER_K = true;
  static __device__ __forceinline__ size_t acol(int pn) { return pn >= 8 ? (size_t)256 : (size_t)0; }
  static constexpr bool PERM = true;
  _Float16* wa; bf16_t* gbuf; const float* decay_w0; const float* aaa_a0;
  __device__ __forceinline__ void operator()(const f32x4 (&acc)[2][2][4][2], const Unit& u, int wr, int wc, int fr, int fq) const {
    const int row0 = u.pm * 256 + wr * 64 + fr; const int grp = u.pn >> 1; const int col0 = (u.pn & 1) * 256 + wc * 32 + 8 * fq;
    if (grp < 4) {
      const float* bias = (grp < 2 ? decay_w0 + grp * 512 : aaa_a0 + (grp - 2) * 512);
      f32x4 bv[2][2];
#pragma unroll
      for (int bj = 0; bj < 2; ++bj)
#pragma unroll
        for (int n = 0; n < 2; ++n) bv[bj][n] = *(const f32x4*)(bias + col0 + bj * 128 + 4 * n);
      _Float16* base = wa + (size_t)grp * MF * 512;
#pragma unroll
      for (int ai = 0; ai < 2; ++ai)
#pragma unroll
        for (int m = 0; m < 4; ++m) { const int row = row0 + ai * 128 + m * 16; if (row < MF) {
#pragma unroll
            for (int bj = 0; bj < 2; ++bj) { f16x8 o;
#pragma unroll
              for (int n = 0; n < 2; ++n)
#pragma unroll
                for (int j = 0; j < 4; ++j) { float s = sigmoidf_(acc[ai][bj][m][n][j] + bv[bj][n][j]); if (grp < 2) s = __expf(-0.6065306597126334f * s); o[n * 4 + j] = (_Float16)s; }
              *(f16x8*)(base + (size_t)row * 512 + col0 + bj * 128) = o; } } }
    } else {
#pragma unroll
      for (int ai = 0; ai < 2; ++ai)
#pragma unroll
        for (int m = 0; m < 4; ++m) { const int row = row0 + ai * 128 + m * 16; if (row < MF) { int T, t, s0, c0; full_decode(row, T, t, s0, c0);
            if (t >= 16) { bf16_t* rowp = gbuf + (size_t)(c0 + t - 16) * 512 + col0;
#pragma unroll
              for (int bj = 0; bj < 2; ++bj) { const f32x4 v0 = acc[ai][bj][m][0], v1 = acc[ai][bj][m][1];
                u32x4 w; w.x = cvt_pk_bf16(v0[0], v0[1]); w.y = cvt_pk_bf16(v0[2], v0[3]); w.z = cvt_pk_bf16(v1[0], v1[1]); w.w = cvt_pk_bf16(v1[2], v1[3]);
                *(u32x4*)(rowp + bj * 128) = w; } } } }
    }
  }
};
struct EpiOut {
  static constexpr bool LAUNDER_K = false;
  static __device__ __forceinline__ size_t acol(int) { return 0; }
  static constexpr bool PERM = false;
  const float* xp; const float* xs; float* out; bf16_t* a2; const float* ln2; float* ssq;
  __device__ __forceinline__ void operator()(const f32x4 (&acc)[2][2][4][2], const Unit& u, int wr, int wc, int fr, int fq) const {
    const int row0 = u.pm * 256 + wr * 64 + fr, col0 = u.pn * 256 + wc * 32 + 4 * fq;
    f32x4 gv[2][2];
#pragma unroll
    for (int bj = 0; bj < 2; ++bj)
#pragma unroll
      for (int n = 0; n < 2; ++n) gv[bj][n] = *(const f32x4*)(ln2 + col0 + bj * 128 + n * 16);
#pragma unroll
    for (int ai = 0; ai < 2; ++ai)
#pragma unroll
      for (int m = 0; m < 4; ++m) { const int row = row0 + ai * 128 + m * 16;
        const float* xr = (row < CP ? xp + (size_t)row * 1024 : xs + (size_t)(row - CP) * 1024) + col0; bf16_t* ar = a2 + (size_t)row * 1024 + col0;
        float ss = 0.f;
#pragma unroll
        for (int bj = 0; bj < 2; ++bj)
#pragma unroll
          for (int n = 0; n < 2; ++n) { const f32x4 v = *(const f32x4*)(xr + bj * 128 + n * 16) + acc[ai][bj][m][n];
            ss += v[0] * v[0] + v[1] * v[1] + v[2] * v[2] + v[3] * v[3]; const f32x4 g = gv[bj][n];
            u32x2 w; w.x = cvt_pk_bf16(v[0] * g[0], v[1] * g[1]); w.y = cvt_pk_bf16(v[2] * g[2], v[3] * g[3]); *(u32x2*)(ar + bj * 128 + n * 16) = w; }
        { auto r = __builtin_amdgcn_permlane16_swap(__float_as_uint(ss), __float_as_uint(ss), false, false); ss = __uint_as_float(r[0]) + __uint_as_float(r[1]); }
        { auto r = __builtin_amdgcn_permlane32_swap(__float_as_uint(ss), __float_as_uint(ss), false, false); ss = __uint_as_float(r[0]) + __uint_as_float(r[1]); }
        if (fq == 0) atomicAdd(ssq + row, ss); }
  }
};
struct EpiGU {
  static constexpr bool LAUNDER_K = false;
  static __device__ __forceinline__ size_t acol(int) { return 0; }
  static constexpr bool PERM = true;
  bf16_t* hmid; const float* ssq;
  __device__ __forceinline__ void operator()(const f32x4 (&acc)[2][2][4][2], const Unit& u, int wr, int wc, int fr, int fq) const {
    const int row0 = u.pm * 256 + wr * 64 + fr, j0 = u.pn * 128 + wc * 16 + 4 * fq;
#pragma unroll
    for (int ai = 0; ai < 2; ++ai)
#pragma unroll
      for (int m = 0; m < 4; ++m) { const int row = row0 + ai * 128 + m * 16; bf16_t* rowp = hmid + (size_t)row * DFF + j0;
        const float rs = rsqrtf(ssq[row] * (1.0f / 1024.0f) + 1e-6f);
#pragma unroll
        for (int bj = 0; bj < 2; ++bj) { const f32x4 g = acc[ai][bj][m][0] * rs, up = acc[ai][bj][m][1] * rs; float h[4];
#pragma unroll
          for (int j = 0; j < 4; ++j) h[j] = g[j] * sigmoidf_(g[j]) * up[j];
          u32x2 w; w.x = cvt_pk_bf16(h[0], h[1]); w.y = cvt_pk_bf16(h[2], h[3]); *(u32x2*)(rowp + bj * 64) = w; } }
  }
};
struct EpiDown {
  static constexpr bool LAUNDER_K = false;
  static __device__ __forceinline__ size_t acol(int) { return 0; }
  static constexpr bool PERM = false;
  float* out; const bf16_t* a2; const float* ln2;
  __device__ __forceinline__ void operator()(const f32x4 (&acc)[2][2][4][2], const Unit& u, int wr, int wc, int fr, int fq) const {
    const int row0 = u.pm * 256 + wr * 64 + fr, col0 = u.pn * 256 + wc * 32 + 4 * fq;
    f32x4 gi[2][2];
#pragma unroll
    for (int bj = 0; bj < 2; ++bj)
#pragma unroll
      for (int n = 0; n < 2; ++n) { const f32x4 g = *(const f32x4*)(ln2 + col0 + bj * 128 + n * 16); gi[bj][n] = (f32x4){__builtin_amdgcn_rcpf(g[0]), __builtin_amdgcn_rcpf(g[1]), __builtin_amdgcn_rcpf(g[2]), __builtin_amdgcn_rcpf(g[3])}; }
#pragma unroll
    for (int ai = 0; ai < 2; ++ai)
#pragma unroll
      for (int m = 0; m < 4; ++m) { const size_t off = (size_t)(row0 + ai * 128 + m * 16) * 1024 + col0;
#pragma unroll
        for (int bj = 0; bj < 2; ++bj)
#pragma unroll
          for (int n = 0; n < 2; ++n) { const u32x2 w = *(const u32x2*)(a2 + off + bj * 128 + n * 16); const f32x4 x1 = (f32x4){bflo(w.x), bfhi(w.x), bflo(w.y), bfhi(w.y)} * gi[bj][n];
            *(f32x4*)(out + off + bj * 128 + n * 16) = x1 + acc[ai][bj][m][n]; } }
  }
};

template <class F> __device__ __forceinline__ void tr_tile(float* tile, bf16_t* dst, int ldk, int k0, int n0, F val) {
  const int tid = tid_();
#pragma unroll
  for (int i = 0; i < 8; ++i) { const int kk = (tid >> 6) + 8 * i, nn = tid & 63; tile[nn * 65 + kk] = val(k0 + kk, n0 + nn); }
  __syncthreads();
#pragma unroll
  for (int i = 0; i < 8; ++i) { const int nn = (tid >> 6) + 8 * i, kk = tid & 63; dst[(size_t)(n0 + nn) * ldk + k0 + kk] = f2bf(tile[nn * 65 + kk]); }
  __syncthreads();
}
__device__ void phase0(const Params& p, unsigned char* shm) {
  float* tile = (float*)shm;
  const float* w_in = p.in[4]; const float* mix_w = p.in[6]; const float* mix_a = p.in[7]; const float* mix_g = p.in[8];
  const float* dw1 = p.in[10]; const float* dw2 = p.in[11]; const float* aa1 = p.in[13]; const float* aa2 = p.in[14]; const float* g1 = p.in[15]; const float* g2 = p.in[16];
  const float* w_out = p.in[26]; const float* w_gate = p.in[28]; const float* w_up = p.in[29]; const float* w_down = p.in[30];
  bf16_t* W_in = (bf16_t*)(p.ws + WS_WIN); bf16_t* W_2 = (bf16_t*)(p.ws + WS_W2); bf16_t* W_out = (bf16_t*)(p.ws + WS_WOUT); bf16_t* W_gu = (bf16_t*)(p.ws + WS_WGU); bf16_t* W_dn = (bf16_t*)(p.ws + WS_WDN);
  const int tidx = tid_();
  if (blockIdx.x == 0 && tidx < 256) ((unsigned*)(p.ws + WS_MISC))[tidx] = 0u;
  for (int i = blockIdx.x * 512 + tidx; i < MC; i += gridDim.x * 512) ((float*)(p.ws + WS_SSQ))[i] = 0.f;
  for (int i = blockIdx.x * 512 + tidx; i < TS * 8; i += gridDim.x * 512) { const int t = i >> 3, e = i & 7; const float fr = exp2f(-(float)e * 0.125f * 18.931568569324174f); float sn, cs; sincosf((float)t * fr, &sn, &cs);
    float* rt = (float*)(p.ws + WS_ROPE) + (size_t)t * 16; rt[e] = cs; rt[8 + e] = sn; }
  constexpr int NT_A = 64 * 16, NT_B = 40 * 4, NT_C = 16 * 16, NT_D = 88 * 16, NT_E = 16 * 44;
  for (int it = blockIdx.x; it < NT_A + NT_B + NT_C + NT_D + NT_E; it += gridDim.x) {
    int i = it;
    if (i < NT_A) { const int n0 = (i >> 4) * 64, k0 = (i & 15) * 64;
      tr_tile(tile, W_in, 1024, k0, n0, [&](int k, int n) -> float {
        if (n < 3072) return w_in[(size_t)k * 3072 + n];
        int j = n - 3072; if (j >= 832) return 0.f; const bool isQ = j >= 416; if (isQ) j -= 416;
        float w, mx;
        if (j < 128) { const int d = j >> 6; w = dw1[((size_t)d * 1024 + k) * 64 + (j & 63)]; mx = mix_w[d * 1024 + k]; }
        else if (j < 256) { const int d = (j - 128) >> 6; w = aa1[((size_t)d * 1024 + k) * 64 + (j & 63)]; mx = mix_a[d * 1024 + k]; }
        else { w = g1[(size_t)k * 160 + (j - 256)]; mx = mix_g[k]; }
        return isQ ? 0.5f * mx * w : (1.0f - mx) * w; });
      continue; }
    i -= NT_A;
    if (i < NT_B) { const int n0 = (i >> 2) * 64, k0 = (i & 3) * 64;
      tr_tile(tile, W_2, 256, k0, n0, [&](int k, int n) -> float {
        const int grp = n >> 9, c = n & 511;
        if (grp < 2) { const int kk = k - grp * 64; return (kk >= 0 && kk < 64) ? dw2[((size_t)grp * 64 + kk) * 512 + c] : 0.f; }
        if (grp < 4) { const int kk = k - grp * 64; return (kk >= 0 && kk < 64) ? aa2[((size_t)(grp - 2) * 64 + kk) * 512 + c] : 0.f; }
        return k < 160 ? g2[(size_t)k * 512 + c] : 0.f; });
      continue; }
    i -= NT_B;
    if (i < NT_C) { const int n0 = (i >> 4) * 64, k0 = (i & 15) * 64;
      tr_tile(tile, W_out, 1024, k0, n0, [&](int k, int n) -> float { const int ks = k < 512 ? k + 512 : k - 512; return w_out[(size_t)ks * 1024 + n]; });
      continue; }
    i -= NT_C;
    if (i < NT_D) { const int n0 = (i >> 4) * 64, k0 = (i & 15) * 64;
      tr_tile(tile, W_gu, 1024, k0, n0, [&](int k, int n) -> float { const int q = n >> 3, e = n & 7; return e < 4 ? w_gate[(size_t)k * DFF + 4 * q + e] : w_up[(size_t)k * DFF + 4 * q + e - 4]; });
      continue; }
    i -= NT_D;
    { const int n0 = (i / 44) * 64, k0 = (i % 44) * 64;
      tr_tile(tile, W_dn, DFF, k0, n0, [&](int k, int n) -> float { return w_down[(size_t)k * 1024 + n]; }); }
  }
  const float* xp = p.in[0]; const float* xs = p.in[1]; const float* meta = p.in[2]; const float* ln1 = p.in[3];
  bf16_t* N1 = (bf16_t*)(p.ws + WS_R3);
  const int lane = tidx & 63, gw = blockIdx.x * 8 + (tidx >> 6), nw = gridDim.x * 8;
  f32x4 gv[4];
#pragma unroll
  for (int i = 0; i < 4; ++i) gv[i] = *(const f32x4*)(ln1 + i * 256 + lane * 4);
  for (int r = gw; r < MF; r += nw) {
    int T, t, s0, c0; full_decode(r, T, t, s0, c0);
    const float* src = t < 16 ? meta + t * 1024 : (r < MP ? xp + (size_t)(c0 + t - 16) * 1024 : xs + (size_t)(c0 - CP + t - 16) * 1024);
    f32x4 v[4]; float ss = 0.f;
#pragma unroll
    for (int i = 0; i < 4; ++i) { v[i] = *(const f32x4*)(src + i * 256 + lane * 4); ss += v[i][0] * v[i][0] + v[i][1] * v[i][1] + v[i][2] * v[i][2] + v[i][3] * v[i][3]; }
    ss = wave_sum(ss);
    const float rs = rsqrtf(ss * (1.0f / 1024.0f) + 1e-6f);
#pragma unroll
    for (int i = 0; i < 4; ++i) { u32x2 w; w.x = cvt_pk_bf16(v[i][0] * rs * gv[i][0], v[i][1] * rs * gv[i][1]); w.y = cvt_pk_bf16(v[i][2] * rs * gv[i][2], v[i][3] * rs * gv[i][3]);
      *(u32x2*)(N1 + (size_t)r * 1024 + i * 256 + lane * 4) = w; }
  }
}

__device__ void phase15(const Params& p) {
  const bf16_t* PQ = (const bf16_t*)(p.ws + WS_R2); bf16_t* L1 = (bf16_t*)(p.ws + WS_R4); bf16_t* QKVD = (bf16_t*)(p.ws + WS_R1);
  const float* qg = p.in[22]; const float* kg = p.in[23];
  const int tidx = tid_();
  const int lane = tidx & 63, gw = blockIdx.x * 8 + (tidx >> 6), nw = gridDim.x * 8;
  const int sub = lane & 3, grpi = lane >> 2;
  float gq[16];
#pragma unroll
  for (int e = 0; e < 16; ++e) gq[e] = (grpi < 8 ? qg : kg)[sub * 16 + e];
  for (int r = gw; r < MF; r += nw) {
    int T, t, s0, c0; full_decode(r, T, t, s0, c0);
    { const int j0 = lane * 8; u32x4 o = {0u, 0u, 0u, 0u};
      if (j0 < 416) {
        const u32x4 pv = *(const u32x4*)(PQ + (size_t)r * 1024 + j0);
        u32x4 qa = {0u, 0u, 0u, 0u}, qb = {0u, 0u, 0u, 0u};
        if (t > 0) qa = *(const u32x4*)(PQ + (size_t)(r - 1) * 1024 + 416 + j0);
        if (t < T - 1) qb = *(const u32x4*)(PQ + (size_t)(r + 1) * 1024 + 416 + j0);
        float s[8];
#pragma unroll
        for (int e = 0; e < 4; ++e) { s[2 * e] = bflo(pv[e]) + bflo(qa[e]) + bflo(qb[e]); s[2 * e + 1] = bfhi(pv[e]) + bfhi(qa[e]) + bfhi(qb[e]); }
        if (j0 < 128) {
#pragma unroll
          for (int e = 0; e < 8; ++e) s[e] = tanhf(s[e]);
        } else if (j0 >= 256) {
#pragma unroll
          for (int e = 0; e < 8; ++e) s[e] = sigmoidf_(s[e]);
        }
#pragma unroll
        for (int e = 0; e < 4; ++e) o[e] = cvt_pk_bf16(s[2 * e], s[2 * e + 1]);
      }
      *(u32x4*)(L1 + (size_t)r * 512 + j0) = o; }
    { bf16_t* ptr = QKVD + (size_t)r * LDQ + lane * 16;
      const u32x4 a = *(const u32x4*)ptr, b = *(const u32x4*)(ptr + 8);
      float x[16];
#pragma unroll
      for (int e = 0; e < 4; ++e) { x[2 * e] = bflo(a[e]); x[2 * e + 1] = bfhi(a[e]); x[8 + 2 * e] = bflo(b[e]); x[9 + 2 * e] = bfhi(b[e]); }
      float ss = 0.f;
#pragma unroll
      for (int e = 0; e < 16; ++e) ss += x[e] * x[e];
      ss = quad_sum(ss);
      const float rs = rsqrtf(ss * (1.0f / 64.0f) + 1e-6f);
#pragma unroll
      for (int e = 0; e < 16; ++e) x[e] = x[e] * rs * gq[e];
      if (sub == 0) {
        const f32x4* rt = (const f32x4*)((const float*)(p.ws + WS_ROPE) + (size_t)t * 16);
        const f32x4 c0 = rt[0], c1 = rt[1], s0 = rt[2], s1 = rt[3];
        const float cs[8] = {c0[0], c0[1], c0[2], c0[3], c1[0], c1[1], c1[2], c1[3]}, sn[8] = {s0[0], s0[1], s0[2], s0[3], s1[0], s1[1], s1[2], s1[3]};
#pragma unroll
        for (int e = 0; e < 8; ++e) { const float x1 = x[e], x2 = x[e + 8]; x[e] = x1 * cs[e] - x2 * sn[e]; x[e + 8] = x2 * cs[e] + x1 * sn[e]; }
      }
      u32x4 oa, ob;
#pragma unroll
      for (int e = 0; e < 4; ++e) { oa[e] = cvt_pk_bf16(x[2 * e], x[2 * e + 1]); ob[e] = cvt_pk_bf16(x[8 + 2 * e], x[9 + 2 * e]); }
      *(u32x4*)ptr = oa; *(u32x4*)(ptr + 8) = ob; }
  }
}

__device__ void scan_wave(const Params& p, int sample, int b, int h, int dir, int rowpart, LAS float* vec) {
  const int lane = tid_() & 63, q = lane & 3, il = lane >> 2, irow = rowpart * 16 + il;
  const int T = sample ? TS : TP; const int seq0 = sample ? MP + b * TS : b * TP; const int cseq0 = sample ? CP + b * SS : b * SP;
  const bf16_t* RKV = (const bf16_t*)p.out; const _Float16* WA = (const _Float16*)(p.ws + WS_R2);
  bf16_t* Y = (bf16_t*)(p.ws + (dir ? WS_R4 : WS_R3)); float* BON = (float*)(p.ws + WS_BON) + (size_t)dir * MC * 8;
  const float* conv = p.in[5]; const int hj = h * 64 + lane;
  const float cAr = conv[(dir ? 2 : 0) * 1536 + hj], c1r = conv[1536 + hj], cCr = conv[(dir ? 0 : 2) * 1536 + hj];
  const float cAk = conv[(dir ? 2 : 0) * 1536 + 512 + hj], c1k = conv[1536 + 512 + hj], cCk = conv[(dir ? 0 : 2) * 1536 + 512 + hj];
  const float cAv = conv[(dir ? 2 : 0) * 1536 + 1024 + hj], c1v = conv[1536 + 1024 + hj], cCv = conv[(dir ? 0 : 2) * 1536 + 1024 + hj];
  const float kkc = p.in[17][hj], kac = p.in[18][hj], rkc = p.in[19][hj];
  const int ds = dir ? -1 : 1; const int tstart = dir ? T - 1 : 0; const int nsteps = dir ? T - 16 : T;
  const bf16_t* rk = RKV + (size_t)seq0 * LDQ + hj; const _Float16* wp = WA + ((size_t)dir * MF + seq0) * 512 + hj; const _Float16* ap = WA + ((size_t)(2 + dir) * MF + seq0) * 512 + hj;
  struct Raw { unsigned r, k, v; };
  auto ldraw = [&](int t) -> Raw { const int tc = min(max(t, 0), T - 1); const bf16_t* pp = rk + (size_t)tc * LDQ; Raw x; x.r = pp[0]; x.k = pp[512]; x.v = pp[1024]; return x; };
  auto valid = [&](int t) -> float { return (t >= 0 && t < T) ? 1.0f : 0.0f; };
  auto ldw = [&](int t) -> _Float16 { const int tc = min(max(t, 0), T - 1); return wp[(size_t)tc * 512]; };
  auto lda = [&](int t) -> _Float16 { const int tc = min(max(t, 0), T - 1); return ap[(size_t)tc * 512]; };
  auto prep = [&](LAS float* buf, int t, bool live, float Ar, float Ak, float Av, float Br, float Bk, float Bv, float Cr, float Ck, float Cv, float w, float a) {
    const float rc = cAr * Ar + c1r * Br + cCr * Cr, kc = cAk * Ak + c1k * Bk + cCk * Ck, vc = cAv * Av + c1v * Bv + cCv * Cv;
    const float kkv = kc * kkc, kd = kc * (1.0f + (a - 1.0f) * kac);
    const float ssq = wave_sum(kkv * kkv), bsum = wave_sum(rc * kd * rkc);
    const float kk = kkv * __builtin_amdgcn_rsqf(fmaxf(ssq, 1e-24f));
    buf[lane] = -kk; buf[64 + lane] = w; buf[128 + lane] = kk * a; buf[192 + lane] = kd; buf[256 + lane] = rc; buf[320 + lane] = vc;
    if (live && t >= 16 && rowpart == 0 && lane == 0) BON[(size_t)(cseq0 + t - 16) * 8 + h] = bsum;
  };
  float W0r, W0k, W0v, W1r, W1k, W1v, W2r, W2k, W2v, w1, a1;
  { const Raw x0 = ldraw(tstart), x1 = ldraw(tstart + ds), x2 = ldraw(tstart + 2 * ds);
    W0r = bf2f((bf16_t)x0.r); W0k = bf2f((bf16_t)x0.k); W0v = bf2f((bf16_t)x0.v);
    W1r = bf2f((bf16_t)x1.r); W1k = bf2f((bf16_t)x1.k); W1v = bf2f((bf16_t)x1.v);
    W2r = bf2f((bf16_t)x2.r); W2k = bf2f((bf16_t)x2.k); W2v = bf2f((bf16_t)x2.v);
    prep(vec, tstart, true, 0.f, 0.f, 0.f, W0r, W0k, W0v, W1r, W1k, W1v, (float)ldw(tstart), (float)lda(tstart));
    w1 = (float)ldw(tstart + ds); a1 = (float)lda(tstart + ds); }
  Raw L = ldraw(tstart + 3 * ds); _Float16 Lw = ldw(tstart + 2 * ds), La = lda(tstart + 2 * ds);
  float S[16];
#pragma unroll
  for (int j = 0; j < 16; ++j) S[j] = 0.f;
  for (int n = 0; n < nsteps; ++n) {
    const int t = tstart + n * ds;
    const Raw Nx = ldraw(t + 4 * ds); const _Float16 Nw = ldw(t + 3 * ds), Na = lda(t + 3 * ds);
    const LAS f32x4* v4 = (const LAS f32x4*)(vec + (n & 1) * 384);
    float av[16], wv[16], bv[16], kv[16], rv[16];
#pragma unroll
    for (int j = 0; j < 4; ++j) { const f32x4 a4 = v4[q * 4 + j], w4 = v4[16 + q * 4 + j], b4 = v4[32 + q * 4 + j], k4 = v4[48 + q * 4 + j], r4 = v4[64 + q * 4 + j];
#pragma unroll
      for (int e = 0; e < 4; ++e) { av[4 * j + e] = a4[e]; wv[4 * j + e] = w4[e]; bv[4 * j + e] = b4[e]; kv[4 * j + e] = k4[e]; rv[4 * j + e] = r4[e]; } }
    const float vi = (vec + (n & 1) * 384)[320 + irow];
    prep(vec + ((n + 1) & 1) * 384, t + ds, n + 1 < nsteps, W0r, W0k, W0v, W1r, W1k, W1v, W2r, W2k, W2v, w1, a1);
    float sa0 = 0.f, sa1 = 0.f;
#pragma unroll
    for (int j = 0; j < 16; j += 2) { sa0 = fmaf(S[j], av[j], sa0); sa1 = fmaf(S[j + 1], av[j + 1], sa1); }
    const float sa = quad_sum(sa0 + sa1);
    float y0 = 0.f, y1 = 0.f;
#pragma unroll
    for (int j = 0; j < 16; j += 2) {
      S[j] = fmaf(S[j], wv[j], fmaf(sa, bv[j], vi * kv[j])); S[j + 1] = fmaf(S[j + 1], wv[j + 1], fmaf(sa, bv[j + 1], vi * kv[j + 1]));
      y0 = fmaf(S[j], rv[j], y0); y1 = fmaf(S[j + 1], rv[j + 1], y1); }
    const float y = quad_sum(y0 + y1);
    if (t >= 16 && q == 0) Y[(size_t)(cseq0 + t - 16) * 512 + h * 64 + irow] = f2bf(y);
    { const float vl = valid(t + 3 * ds);
      W0r = W1r; W0k = W1k; W0v = W1v; W1r = W2r; W1k = W2k; W1v = W2v;
      W2r = bf2f((bf16_t)L.r) * vl; W2k = bf2f((bf16_t)L.k) * vl; W2v = bf2f((bf16_t)L.v) * vl;
      w1 = (float)Lw; a1 = (float)La; L = Nx; Lw = Nw; La = Na; }
    asm volatile("" ::: "memory");
  }
}

__device__ void scan_block(const Params& p, int sample, int b, int h, int dir, LAS float* ring) {
  const int tid = tid_(), wid = __builtin_amdgcn_readfirstlane(tid >> 6), lane = tid & 63;
  const int T = sample ? TS : TP; const int seq0 = sample ? MP + b * TS : b * TP; const int cseq0 = sample ? CP + b * SS : b * SP;
  const int ds = dir ? -1 : 1; const int tstart = dir ? T - 1 : 0; const int nsteps = dir ? T - 16 : T; const int nchunks = nsteps >> 3;
  if (wid >= 4) {
    const int pw = wid - 4, hj = h * 64 + lane;
    const bf16_t* RKV = (const bf16_t*)p.out; const _Float16* WA = (const _Float16*)(p.ws + WS_R2);
    float* BON = (float*)(p.ws + WS_BON) + (size_t)dir * MC * 8; const float* conv = p.in[5];
    const float cAr = conv[(dir ? 2 : 0) * 1536 + hj], c1r = conv[1536 + hj], cCr = conv[(dir ? 0 : 2) * 1536 + hj];
    const float cAk = conv[(dir ? 2 : 0) * 1536 + 512 + hj], c1k = conv[1536 + 512 + hj], cCk = conv[(dir ? 0 : 2) * 1536 + 512 + hj];
    const float cAv = conv[(dir ? 2 : 0) * 1536 + 1024 + hj], c1v = conv[1536 + 1024 + hj], cCv = conv[(dir ? 0 : 2) * 1536 + 1024 + hj];
    const float kkc = p.in[17][hj], kac = p.in[18][hj], rkc = p.in[19][hj];
    const bf16_t* rk = RKV + (size_t)seq0 * LDQ + hj; const _Float16* wp = WA + ((size_t)dir * MF + seq0) * 512 + hj; const _Float16* ap = WA + ((size_t)(2 + dir) * MF + seq0) * 512 + hj;
    struct In { unsigned r0, k0, v0, r1, k1, v1, r2, k2, v2; _Float16 w, a; };
    auto load_step = [&](int n) -> In { const int t = tstart + n * ds; const int ta = min(max(t - ds, 0), T - 1), tb = min(max(t, 0), T - 1), tc = min(max(t + ds, 0), T - 1);
      const bf16_t* pa = rk + (size_t)ta * LDQ; const bf16_t* pb = rk + (size_t)tb * LDQ; const bf16_t* pc = rk + (size_t)tc * LDQ; In x;
      x.r0 = pa[0]; x.k0 = pa[512]; x.v0 = pa[1024]; x.r1 = pb[0]; x.k1 = pb[512]; x.v1 = pb[1024]; x.r2 = pc[0]; x.k2 = pc[512]; x.v2 = pc[1024];
      x.w = wp[(size_t)tb * 512]; x.a = ap[(size_t)tb * 512]; return x; };
    auto prep = [&](const In& x, int n, LAS float* buf) { const int t = tstart + n * ds;
      const float va = (t - ds >= 0 && t - ds < T) ? 1.f : 0.f, vc_ = (t + ds >= 0 && t + ds < T) ? 1.f : 0.f;
      const float Ar = bf2f((bf16_t)x.r0) * va, Ak = bf2f((bf16_t)x.k0) * va, Av = bf2f((bf16_t)x.v0) * va, Cr = bf2f((bf16_t)x.r2) * vc_, Ck = bf2f((bf16_t)x.k2) * vc_, Cv = bf2f((bf16_t)x.v2) * vc_;
      const float Br = bf2f((bf16_t)x.r1), Bk = bf2f((bf16_t)x.k1), Bv = bf2f((bf16_t)x.v1), w = (float)x.w, a = (float)x.a;
      const float rc = cAr * Ar + c1r * Br + cCr * Cr, kc = cAk * Ak + c1k * Bk + cCk * Ck, vc = cAv * Av + c1v * Bv + cCv * Cv;
      const float kkv = kc * kkc, kd = kc * (1.0f + (a - 1.0f) * kac);
      const float ssq = wave_sum(kkv * kkv), bsum = wave_sum(rc * kd * rkc);
      const float kk = kkv * __builtin_amdgcn_rsqf(fmaxf(ssq, 1e-24f));
      buf[lane] = -kk; buf[64 + lane] = w; buf[128 + lane] = kk * a; buf[192 + lane] = kd; buf[256 + lane] = rc; buf[320 + lane] = vc;
      if (n < nsteps && t >= 16 && lane == 0) BON[(size_t)(cseq0 + t - 16) * 8 + h] = bsum; };
    In L0 = load_step(2 * pw), L1 = load_step(2 * pw + 1);
    In N0 = load_step(8 + 2 * pw), N1 = load_step(8 + 2 * pw + 1);
    prep(L0, 2 * pw, ring + (2 * pw) * 384); prep(L1, 2 * pw + 1, ring + (2 * pw + 1) * 384);
    L0 = N0; L1 = N1;
    __syncthreads();
    for (int c = 0; c < nchunks; ++c) {
      N0 = load_step((c + 2) * 8 + 2 * pw); N1 = load_step((c + 2) * 8 + 2 * pw + 1);
      LAS float* dst = ring + (((c + 1) & 1) * 8 + 2 * pw) * 384;
      prep(L0, (c + 1) * 8 + 2 * pw, dst); prep(L1, (c + 1) * 8 + 2 * pw + 1, dst + 384);
      L0 = N0; L1 = N1;
      __syncthreads();
    }
  } else {
    const int q = lane & 3, il = lane >> 2, irow = wid * 16 + il;
    bf16_t* Y = (bf16_t*)(p.ws + (dir ? WS_R4 : WS_R3)) + (size_t)cseq0 * 512 + h * 64 + irow;
    typedef float f32x2 __attribute__((ext_vector_type(2)));
    f32x2 S[8];
#pragma unroll
    for (int j = 0; j < 8; ++j) S[j] = (f32x2){0.f, 0.f};
    __syncthreads();
    for (int c = 0; c < nchunks; ++c) {
#pragma unroll 8
      for (int s8 = 0; s8 < 8; ++s8) {
        const int t = tstart + (c * 8 + s8) * ds;
        const LAS float* buf = ring + ((c & 1) * 8 + s8) * 384; const LAS f32x4* v4 = (const LAS f32x4*)buf;
        f32x2 av[8], wv[8], bv[8], kv[8], rv[8];
#pragma unroll
        for (int j = 0; j < 4; ++j) { const f32x4 a4 = v4[q * 4 + j], w4 = v4[16 + q * 4 + j], b4 = v4[32 + q * 4 + j], k4 = v4[48 + q * 4 + j], r4 = v4[64 + q * 4 + j];
          av[2 * j] = a4.xy; av[2 * j + 1] = a4.zw; wv[2 * j] = w4.xy; wv[2 * j + 1] = w4.zw; bv[2 * j] = b4.xy; bv[2 * j + 1] = b4.zw;
          kv[2 * j] = k4.xy; kv[2 * j + 1] = k4.zw; rv[2 * j] = r4.xy; rv[2 * j + 1] = r4.zw; }
        const float vi = buf[320 + irow];
        f32x2 sa2 = S[0] * av[0], sa3 = S[1] * av[1];
#pragma unroll
        for (int j = 2; j < 8; j += 2) { sa2 = S[j] * av[j] + sa2; sa3 = S[j + 1] * av[j + 1] + sa3; }
        sa2 = sa2 + sa3;
        const float sa = quad_sum(sa2.x + sa2.y);
        const f32x2 sav = (f32x2){sa, sa}, viv = (f32x2){vi, vi};
        f32x2 y2 = (f32x2){0.f, 0.f}, y3 = (f32x2){0.f, 0.f};
#pragma unroll
        for (int j = 0; j < 8; j += 2) { const f32x2 t0 = bv[j] * sav + kv[j] * viv, t1 = bv[j + 1] * sav + kv[j + 1] * viv; S[j] = S[j] * wv[j] + t0; S[j + 1] = S[j + 1] * wv[j + 1] + t1; y2 = S[j] * rv[j] + y2; y3 = S[j + 1] * rv[j + 1] + y3; }
        y2 = y2 + y3;
        const float y = quad_sum(y2.x + y2.y);
        Y[(size_t)(max(t, 16) - 16) * 512] = f2bf(y);
      }
      __syncthreads();
    }
  }
}

#define KSWZ(row, colB) ((row) * 256 + ((colB) ^ (((row) & 7) << 4)))
#define SBAR() __builtin_amdgcn_sched_barrier(0)
constexpr float ATT_SCALE = 0.125f, ATT_THR = 8.f;
constexpr int SHM_V = 64 * 128 * 2, SHM_K = 64 * 128 * 2;
__device__ __forceinline__ int crow(int r, int hi) { return (r & 3) + 8 * (r >> 2) + 4 * hi; }
template <bool MASK> __device__ __forceinline__ void partialSM(f32x16& p0, f32x16& p1, float mnC, int kb, int seq, int hi) {
  constexpr float C = ATT_SCALE * 1.4426950408889634f;
  if (MASK && kb + 64 > seq) {
#pragma unroll
    for (int r = 0; r < 16; ++r) { if (kb + crow(r, hi) >= seq) p0[r] = -1e30f; if (kb + 32 + crow(r, hi) >= seq) p1[r] = -1e30f; }
  }
#pragma unroll
  for (int r = 0; r < 16; ++r) p0[r] = fmaf(p0[r], C, mnC);
#pragma unroll
  for (int r = 0; r < 16; ++r) p1[r] = fmaf(p1[r], C, mnC);
#pragma unroll
  for (int r = 0; r < 16; ++r) p0[r] = __builtin_amdgcn_exp2f(p0[r]);
}
__device__ __forceinline__ void finishSM(f32x16& p0, f32x16& p1, float& l_reg, bf16x8& pa0, bf16x8& pa1, bf16x8& pa2, bf16x8& pa3) {
#pragma unroll
  for (int r = 0; r < 16; ++r) p1[r] = __builtin_amdgcn_exp2f(p1[r]);
  typedef float f32x2v __attribute__((ext_vector_type(2)));
  f32x2v s2 = (f32x2v){p0[0], p0[1]} + (f32x2v){p1[0], p1[1]};
#pragma unroll
  for (int r = 2; r < 16; r += 2) { s2 += (f32x2v){p0[r], p0[r + 1]}; s2 += (f32x2v){p1[r], p1[r + 1]}; }
  float ps = s2.x + s2.y;
  { auto rr = __builtin_amdgcn_permlane32_swap(__float_as_uint(ps), __float_as_uint(ps), false, false);
    ps = __uint_as_float(rr[0]) + __uint_as_float(rr[1]); }
  l_reg += ps;
#define PK4(P, BASE, OUT) do { unsigned a0 = cvt_pk_bf16(P[BASE + 0], P[BASE + 1]), a1 = cvt_pk_bf16(P[BASE + 2], P[BASE + 3]);   \
    unsigned b0 = cvt_pk_bf16(P[BASE + 4], P[BASE + 5]), b1 = cvt_pk_bf16(P[BASE + 6], P[BASE + 7]);                              \
    auto r0 = __builtin_amdgcn_permlane32_swap(a0, b0, false, false); auto r1 = __builtin_amdgcn_permlane32_swap(a1, b1, false, false); \
    u32x4 w = {r0[0], r1[0], r0[1], r1[1]}; OUT = *reinterpret_cast<bf16x8*>(&w); } while (0)
  PK4(p0, 0, pa0); PK4(p0, 8, pa1); PK4(p1, 0, pa2); PK4(p1, 8, pa3);
#undef PK4
}
__device__ __forceinline__ void qkt(f32x16& p0, f32x16& p1, const char* Ks, const bf16x8* qr, int r32, int hi, int comp) {
  p0 = f32x16{}; p1 = f32x16{};
#pragma unroll
  for (int d0 = 0; d0 < 4; ++d0) { const int cb = (comp * 64 + d0 * 16 + hi * 8) * 2;
    const bf16x8 b0 = *reinterpret_cast<const bf16x8*>(Ks + KSWZ(r32, cb));
    const bf16x8 b1 = *reinterpret_cast<const bf16x8*>(Ks + KSWZ(32 + r32, cb));
    p0 = __builtin_amdgcn_mfma_f32_32x32x16_bf16(b0, qr[d0], p0, 0, 0, 0);
    p1 = __builtin_amdgcn_mfma_f32_32x32x16_bf16(b1, qr[d0], p1, 0, 0, 0); }
}
__device__ __forceinline__ int v_st(int k, int c) { const int kk = (k & ~0xC) | ((k & 4) << 1) | ((k & 8) >> 1); return ((kk >> 3) * 4 + (c >> 5)) * 512 + ((kk & 7) * 32 + (c & 31)) * 2; }
__device__ __forceinline__ int v_rd_base(int lane) { return ((lane & 3) << 3) | (((lane >> 2) & 3) << 6) | (((lane >> 4) & 1) << 5) | (((lane >> 5) & 1) << 8); }
constexpr int v_rd_off(int d0, int ks, int half) { return d0 * 512 + ks * 4096 + half * 2048; }
template <int OFF> __device__ __forceinline__ s16x4 tr_read(int vb) {
  s16x4 r; asm volatile("ds_read_b64_tr_b16 %0, %1 offset:%2" : "=&v"(r) : "v"(vb), "i"(OFF) : "memory"); return r;
}
template <int D0> __device__ __forceinline__ void pv_one(f32x16& od, int vb, bf16x8 pa0, bf16x8 pa1, bf16x8 pa2, bf16x8 pa3) {
  const s16x4 l0 = tr_read<v_rd_off(D0, 0, 0)>(vb), h0 = tr_read<v_rd_off(D0, 0, 1)>(vb), l1 = tr_read<v_rd_off(D0, 1, 0)>(vb), h1 = tr_read<v_rd_off(D0, 1, 1)>(vb);
  const s16x4 l2 = tr_read<v_rd_off(D0, 2, 0)>(vb), h2 = tr_read<v_rd_off(D0, 2, 1)>(vb), l3 = tr_read<v_rd_off(D0, 3, 0)>(vb), h3 = tr_read<v_rd_off(D0, 3, 1)>(vb);
  asm volatile("s_waitcnt lgkmcnt(0)" ::: "memory"); SBAR();
#define PK(L, H) (bf16x8){L[0], L[1], L[2], L[3], H[0], H[1], H[2], H[3]}
  od = __builtin_amdgcn_mfma_f32_32x32x16_bf16(pa0, PK(l0, h0), od, 0, 0, 0);
  od = __builtin_amdgcn_mfma_f32_32x32x16_bf16(pa1, PK(l1, h1), od, 0, 0, 0);
  od = __builtin_amdgcn_mfma_f32_32x32x16_bf16(pa2, PK(l2, h2), od, 0, 0, 0);
  od = __builtin_amdgcn_mfma_f32_32x32x16_bf16(pa3, PK(l3, h3), od, 0, 0, 0);
#undef PK
}
__device__ __forceinline__ void pv_d0(f32x16* o, int vb, bf16x8 pa0, bf16x8 pa1, bf16x8 pa2, bf16x8 pa3) {
  pv_one<0>(o[0], vb, pa0, pa1, pa2, pa3); pv_one<1>(o[1], vb, pa0, pa1, pa2, pa3); pv_one<2>(o[2], vb, pa0, pa1, pa2, pa3); pv_one<3>(o[3], vb, pa0, pa1, pa2, pa3);
}

__device__ void attn_item(const Params& p, int sample, int b, int h, int qblk, char* lds, float lam, float mnC) {
  const int seq = (sample ? TS : TP) - DBG_DROP; const int row0 = sample ? MP + b * TS : b * TP;
  bf16_t* base = (bf16_t*)(p.ws + WS_R1) + (size_t)row0 * LDQ;
  const bf16_t* Kh = base + 512 + h * 128; const bf16_t* Vh = base + 1024 + h * 128;
  bf16_t* Qb = base + (size_t)(16 + qblk * 128) * LDQ + h * 128;
  const int tid = tid_(), wid = tid >> 6, lane = tid & 63, r32 = lane & 31, hi = lane >> 5, comp = wid >> 2, qgi = wid & 3;
  char* V_lds = lds; char* K_lds = lds + 2 * SHM_V;
  float* wsl = (float*)(lds + 2 * SHM_V + 2 * SHM_K) + wid * 64; float* li_l = wsl; float* al_l = wsl + 32;
  float l_reg = 0; f32x16 o[4] = {}; bf16x8 qr[4];
  const bf16_t* Qw = Qb + (size_t)(qgi * 32 + r32) * LDQ + comp * 64 + hi * 8;
#pragma unroll
  for (int d0 = 0; d0 < 4; ++d0) qr[d0] = *reinterpret_cast<const bf16x8*>(Qw + d0 * 16);
  const int sr = tid >> 4, sc = (tid & 15) * 8, vst0 = v_st(sr, sc), vst1 = v_st(32 + sr, sc);
  const int vb0 = (int)(uintptr_t)V_lds + v_rd_base(lane);
  struct { bf16x8 vs0, vs1, ks0, ks1; } sr_[2];
  const bf16_t* kp0 = Kh + (size_t)sr * LDQ + sc;
#define SLOAD(i, k0) do { if ((k0) + 64 <= seq) { const size_t _o = (size_t)(k0) * LDQ; \
      sr_[i].vs0 = *reinterpret_cast<const bf16x8*>(kp0 + _o + 512); sr_[i].vs1 = *reinterpret_cast<const bf16x8*>(kp0 + _o + 32 * LDQ + 512); \
      sr_[i].ks0 = *reinterpret_cast<const bf16x8*>(kp0 + _o); sr_[i].ks1 = *reinterpret_cast<const bf16x8*>(kp0 + _o + 32 * LDQ); } else { \
    const int _r0 = min((k0) + sr, seq - 1), _r1 = min((k0) + 32 + sr, seq - 1); const bf16x8 _z = {0, 0, 0, 0, 0, 0, 0, 0}; \
    sr_[i].vs0 = *reinterpret_cast<const bf16x8*>(&Vh[(size_t)_r0 * LDQ + sc]); sr_[i].vs1 = *reinterpret_cast<const bf16x8*>(&Vh[(size_t)_r1 * LDQ + sc]); \
    if ((k0) + sr >= seq) sr_[i].vs0 = _z; if ((k0) + 32 + sr >= seq) sr_[i].vs1 = _z; \
    sr_[i].ks0 = *reinterpret_cast<const bf16x8*>(&Kh[(size_t)_r0 * LDQ + sc]); sr_[i].ks1 = *reinterpret_cast<const bf16x8*>(&Kh[(size_t)_r1 * LDQ + sc]); } } while (0)
#define SLOADF(i, k0) do { const size_t _o = (size_t)(k0) * LDQ; \
      sr_[i].vs0 = *reinterpret_cast<const bf16x8*>(kp0 + _o + 512); sr_[i].vs1 = *reinterpret_cast<const bf16x8*>(kp0 + _o + 32 * LDQ + 512); \
      sr_[i].ks0 = *reinterpret_cast<const bf16x8*>(kp0 + _o); sr_[i].ks1 = *reinterpret_cast<const bf16x8*>(kp0 + _o + 32 * LDQ); } while (0)
#define SWRITE(b_, i) do { *(bf16x8*)(V_lds + (b_) * SHM_V + vst0) = sr_[i].vs0;          \
    *(bf16x8*)(V_lds + (b_) * SHM_V + vst1) = sr_[i].vs1; const int kc = sc * 2;               \
    *(bf16x8*)(K_lds + (b_) * SHM_K + KSWZ(sr, kc)) = sr_[i].ks0;                       \
    *(bf16x8*)(K_lds + (b_) * SHM_K + KSWZ(32 + sr, kc)) = sr_[i].ks1; } while (0)
#define SWAIT() asm volatile("s_waitcnt vmcnt(4)" ::: "memory")
#define RESC(a) do { if (__any((a) < 1.f)) { if (hi == 0) al_l[r32] = (a); asm volatile("s_waitcnt lgkmcnt(0)" ::: "memory"); \
    _Pragma("unroll") for (int d = 0; d < 4; ++d) _Pragma("unroll") for (int r = 0; r < 16; ++r) o[d][r] *= al_l[crow(r, hi)]; } } while (0)
  f32x16 pA0, pA1, pB0, pB1; bf16x8 pa0, pa1, pa2, pa3;
  const int NT = (((seq + 63) >> 6) + 1) & ~1;
  constexpr int SE = 0, SO = 1;
  SLOAD(SE, 0); asm volatile("s_waitcnt vmcnt(0)" ::: "memory"); SWRITE(0, SE); __syncthreads();
  qkt(pA0, pA1, K_lds, qr, r32, hi, comp); partialSM<false>(pA0, pA1, mnC, 0, seq, hi);
  SLOAD(SO, 64); if (2 < NT) SLOAD(SE, 128);
  SWAIT(); SWRITE(1, SO); __syncthreads();
#define ATT_ITER(MSK, LD) do { \
    SBAR(); qkt(pB0, pB1, K_lds + SHM_K, qr, r32, hi, comp); \
    finishSM(pA0, pA1, l_reg, pa0, pa1, pa2, pa3); SBAR(); \
    LD(SO, (j + 2) * 64); SBAR(); \
    pv_d0(o, vb0, pa0, pa1, pa2, pa3); partialSM<MSK>(pB0, pB1, mnC, j * 64, seq, hi); \
    __syncthreads(); SWAIT(); SWRITE(0, SE); \
    __syncthreads(); \
    SBAR(); qkt(pA0, pA1, K_lds, qr, r32, hi, comp); \
    finishSM(pB0, pB1, l_reg, pa0, pa1, pa2, pa3); SBAR(); \
    if (j + 3 < NT) LD(SE, (j + 3) * 64); SBAR(); \
    pv_d0(o, vb0 + SHM_V, pa0, pa1, pa2, pa3); partialSM<MSK>(pA0, pA1, mnC, (j + 1) * 64, seq, hi); \
    __syncthreads(); SWAIT(); SWRITE(1, SO); \
    __syncthreads(); } while (0)
  int j = 1; const int NF = seq >> 6;
  for (; j + 4 <= NF; j += 2) ATT_ITER(false, SLOADF);
  for (; j + 3 < NT; j += 2) ATT_ITER(false, SLOAD);
  ATT_ITER(true, SLOAD);
#undef ATT_ITER
  if ((NT - 1) * 64 >= seq) {
    SBAR(); finishSM(pA0, pA1, l_reg, pa0, pa1, pa2, pa3); SBAR();
    pv_d0(o, vb0, pa0, pa1, pa2, pa3);
  } else {
    SBAR(); qkt(pB0, pB1, K_lds + SHM_K, qr, r32, hi, comp);
    finishSM(pA0, pA1, l_reg, pa0, pa1, pa2, pa3); SBAR();
    pv_d0(o, vb0, pa0, pa1, pa2, pa3); partialSM<true>(pB0, pB1, mnC, (NT - 1) * 64, seq, hi);
    __syncthreads();
    finishSM(pB0, pB1, l_reg, pa0, pa1, pa2, pa3); SBAR();
    pv_d0(o, vb0 + SHM_V, pa0, pa1, pa2, pa3);
  }
  if (hi == 0) li_l[r32] = l_reg; asm volatile("s_waitcnt lgkmcnt(0)" ::: "memory");
  float rli[16];
#pragma unroll
  for (int r = 0; r < 16; ++r) rli[r] = __builtin_amdgcn_rcpf(li_l[crow(r, hi)]);
  __syncthreads();
  float* xch = (float*)lds + qgi * 4096;
  if (comp == 1) {
#pragma unroll
    for (int d = 0; d < 4; ++d)
#pragma unroll
      for (int r = 0; r < 16; ++r) xch[(d * 16 + r) * 64 + lane] = o[d][r] * rli[r] * lam;
  }
  __syncthreads();
  if (comp == 0) {
    const float* sg = p.in[25];
    float gcol[4];
#pragma unroll
    for (int d = 0; d < 4; ++d) gcol[d] = sg[d * 32 + r32] * 0.8f;
#pragma unroll
    for (int r = 0; r < 16; ++r) {
      float ss = 0.f;
#pragma unroll
      for (int d = 0; d < 4; ++d) { o[d][r] = o[d][r] * rli[r] - xch[(d * 16 + r) * 64 + lane]; ss += o[d][r] * o[d][r]; }
      ss = half32_sum(ss);
      const float rs = rsqrtf(ss * (1.0f / 128.0f) + 1e-6f);
      bf16_t* orow = Qb + (size_t)(qgi * 32 + crow(r, hi)) * LDQ + r32;
#pragma unroll
      for (int d = 0; d < 4; ++d) orow[d * 32] = f2bf(o[d][r] * rs * gcol[d]);
    }
  }
#undef SLOAD
#undef SLOADF
#undef SWRITE
#undef SWAIT
#undef RESC
}

constexpr int N_SCAN_S = BS * 8 * 2;
constexpr int N_SCAN_P = BP * 8 * 2;
constexpr int N_ATT_S = BS * 4 * (SS / 128);
constexpr int N_ATT_P = BP * 4 * (SP / 128);
__device__ void phase3(const Params& p, unsigned char* shm) {
  unsigned* ctr = (unsigned*)(p.ws + WS_MISC);
  LAS unsigned* slot = (LAS unsigned*)(shm + 131072 + 512);
  int nrep = NREP_SCAN; asm volatile("" : "+s"(nrep));
  for (int rep = 0; rep < nrep; ++rep)
  { const int tidx = tid_(); const int wid = tidx >> 6;
    for (;;) {
      __syncthreads();
      if (tidx == 0) *slot = atomicAdd(ctr + 32 * rep, 1u);
      __syncthreads();
      const int it = (int)*slot;
      if (it >= N_SCAN_S + N_SCAN_P) break;
      if (it < N_SCAN_S) { const int dir = it & 1, h = (it >> 1) & 7, b = it >> 4; scan_block(p, 1, b, h, dir, (LAS float*)shm); }
      else { const int ch = it - N_SCAN_S; const int dir = ch & 1, h = (ch >> 1) & 7, b = ch >> 4; scan_block(p, 0, b, h, dir, (LAS float*)shm); }
    } }
  { const int tidx = tid_(); const int lane = tidx & 63;
    const float* dl = p.in[24];
    float lam = __expf(wave_sum(dl[lane] * dl[64 + lane])) - __expf(wave_sum(dl[128 + lane] * dl[192 + lane])) + 0.2f;
#ifdef DBG_LAM0
    lam = 0.f;
#endif
    float gq = fabsf(p.in[22][lane]), gk = fabsf(p.in[23][lane]);
    for (int o = 1; o < 64; o <<= 1) { gq = fmaxf(gq, __shfl_xor(gq, o)); gk = fmaxf(gk, __shfl_xor(gk, o)); }
    const float mnC = -fminf(8.0f * gq * gk * 1.01f, 80.0f) * 1.4426950408889634f;
    for (;;) {
      __syncthreads();
      if (tidx == 0) *slot = atomicAdd(ctr + 16, 1u);
      __syncthreads();
      const int a = (int)*slot;
      if (a >= N_ATT_S + N_ATT_P) break;
      if (a < N_ATT_S) { const int qblk = a & 63, h = (a >> 6) & 3, b = a >> 8; attn_item(p, 1, b, h, qblk, (char*)shm, lam, mnC); }
      else { const int a2 = a - N_ATT_S; const int qblk = a2 & 15, h = (a2 >> 4) & 3, b = a2 >> 6; attn_item(p, 0, b, h, qblk, (char*)shm, lam, mnC); }
    } }
}

__device__ void phase4(const Params& p) {
  const bf16_t* YA = (const bf16_t*)(p.ws + WS_R3); const bf16_t* G = YA + (size_t)MC * 512; const bf16_t* YB = (const bf16_t*)(p.ws + WS_R4);
  const float* BON = (const float*)(p.ws + WS_BON); const bf16_t* RKV = (const bf16_t*)p.out; bf16_t* QKVD = (bf16_t*)(p.ws + WS_R1);
  const float* conv = p.in[5]; const float* lg = p.in[20]; const float* lb = p.in[21];
  const int tidx = tid_();
  const int lane = tidx & 63, gw = blockIdx.x * 8 + (tidx >> 6), nw = gridDim.x * 8, col = lane * 8, head = lane >> 3;
  float c0[8], c1[8], c2[8], lgv[8], lbv[8];
#pragma unroll
  for (int e = 0; e < 8; ++e) { c0[e] = conv[1024 + col + e]; c1[e] = conv[1536 + 1024 + col + e]; c2[e] = conv[3072 + 1024 + col + e]; lgv[e] = lg[col + e]; lbv[e] = lb[col + e]; }
  for (int c = gw; c < MC; c += nw) {
    const int r = compact_to_full(c); const bool has_next = (c < CP ? (c & 2047) != 2047 : ((c - CP) & 8191) != 8191);
    const u32x4 ya = *(const u32x4*)(YA + (size_t)c * 512 + col), yb = *(const u32x4*)(YB + (size_t)c * 512 + col), gg = *(const u32x4*)(G + (size_t)c * 512 + col);
    const u32x4 vm = *(const u32x4*)(RKV + (size_t)(r - 1) * LDQ + 1024 + col), v0 = *(const u32x4*)(RKV + (size_t)r * LDQ + 1024 + col);
    u32x4 vp = {0u, 0u, 0u, 0u}; if (has_next) vp = *(const u32x4*)(RKV + (size_t)(r + 1) * LDQ + 1024 + col);
    const float bon = BON[(size_t)c * 8 + head] + BON[((size_t)MC + c) * 8 + head];
    float y[8], g[8], vc[8];
#pragma unroll
    for (int e = 0; e < 4; ++e) { y[2 * e] = bflo(ya[e]) + bflo(yb[e]); y[2 * e + 1] = bfhi(ya[e]) + bfhi(yb[e]); g[2 * e] = bflo(gg[e]); g[2 * e + 1] = bfhi(gg[e]);
      vc[2 * e] = c0[2 * e] * bflo(vm[e]) + c1[2 * e] * bflo(v0[e]) + c2[2 * e] * bflo(vp[e]); vc[2 * e + 1] = c0[2 * e + 1] * bfhi(vm[e]) + c1[2 * e + 1] * bfhi(v0[e]) + c2[2 * e + 1] * bfhi(vp[e]); }
    float s = 0.f;
#pragma unroll
    for (int e = 0; e < 8; ++e) s += y[e];
    s = oct_sum(s);
    const float mu = s * (1.0f / 64.0f); float qv = 0.f;
#pragma unroll
    for (int e = 0; e < 8; ++e) { const float d = y[e] - mu; qv += d * d; }
    qv = oct_sum(qv);
    const float rs = rsqrtf(qv * (1.0f / 64.0f) + 64e-5f);
    u32x4 o;
#pragma unroll
    for (int e = 0; e < 4; ++e) { const float a = ((y[2 * e] - mu) * rs * lgv[2 * e] + lbv[2 * e] + bon * vc[2 * e]) * g[2 * e], bq = ((y[2 * e + 1] - mu) * rs * lgv[2 * e + 1] + lbv[2 * e + 1] + bon * vc[2 * e + 1]) * g[2 * e + 1];
      o[e] = cvt_pk_bf16(a, bq); }
    *(u32x4*)(QKVD + (size_t)r * LDQ + 512 + col) = o;
  }
}

__device__ void phase5b(const Params& p) {
  const float* X1 = p.out; const float* ln2 = p.in[27]; bf16_t* N2 = (bf16_t*)(p.ws + WS_R3);
  const int tidx = tid_();
  const int lane = tidx & 63, gw = blockIdx.x * 8 + (tidx >> 6), nw = gridDim.x * 8;
  f32x4 gv[4];
#pragma unroll
  for (int i = 0; i < 4; ++i) gv[i] = *(const f32x4*)(ln2 + i * 256 + lane * 4);
  for (int c = gw; c < MC; c += nw) {
    f32x4 v[4]; float ss = 0.f;
#pragma unroll
    for (int i = 0; i < 4; ++i) { v[i] = *(const f32x4*)(X1 + (size_t)c * 1024 + i * 256 + lane * 4); ss += v[i][0] * v[i][0] + v[i][1] * v[i][1] + v[i][2] * v[i][2] + v[i][3] * v[i][3]; }
    ss = wave_sum(ss);
    const float rs = rsqrtf(ss * (1.0f / 1024.0f) + 1e-6f);
#pragma unroll
    for (int i = 0; i < 4; ++i) { u32x2 w; w.x = cvt_pk_bf16(v[i][0] * rs * gv[i][0], v[i][1] * rs * gv[i][1]); w.y = cvt_pk_bf16(v[i][2] * rs * gv[i][2], v[i][3] * rs * gv[i][3]);
      *(u32x2*)(N2 + (size_t)c * 1024 + i * 256 + lane * 4) = w; }
  }
}


#ifndef DBG_SEL
#define DBG_SEL 0
#define DBG_WHICH 0
#endif
#if DBG_SEL
constexpr size_t DBG_SCR = (size_t)320 << 20;
__device__ void dbg_attn_pre(const Params& p, LAS float* lds, float lam) {
  const int tid = tid_(), wid = tid >> 6, lane = tid & 63;
  if (blockIdx.x != 0) return;
  const int sample = wid >> 2; const int b = sample ? 2 : 5 + wid, h = wid & 3; const int T = (sample ? TS : TP) - DBG_DROP; const int row0 = sample ? MP + b * TS : b * TP;
  const int t = 16 + (sample ? 4000 + 1000 * (wid & 3) : 37 + 601 * (wid & 3));
  const bf16_t* base = (const bf16_t*)(p.ws + WS_R1) + (size_t)row0 * LDQ;
  LAS float* qs = lds + wid * 128;
  qs[lane] = bf2f(base[(size_t)t * LDQ + h * 128 + lane]); qs[64 + lane] = bf2f(base[(size_t)t * LDQ + h * 128 + 64 + lane]);
  float* sc = (float*)((char*)p.out + DBG_SCR) + (size_t)wid * 2 * 8320;
  float* ex = (float*)((char*)p.out + DBG_SCR) + (size_t)8 * 2 * 8320 + wid * 128;
  asm volatile("s_waitcnt lgkmcnt(0)" ::: "memory");
  float m0 = -1e30f, m1 = -1e30f;
  for (int k = lane; k < T; k += 64) { const bf16_t* kr = base + (size_t)k * LDQ + 512 + h * 128; float s0 = 0.f, s1 = 0.f;
    for (int d = 0; d < 64; ++d) { s0 += qs[d] * bf2f(kr[d]); s1 += qs[64 + d] * bf2f(kr[64 + d]); }
    s0 *= 0.125f; s1 *= 0.125f; sc[k] = s0; sc[8320 + k] = s1; m0 = fmaxf(m0, s0); m1 = fmaxf(m1, s1); }
  for (int o = 1; o < 64; o <<= 1) { m0 = fmaxf(m0, __shfl_xor(m0, o)); m1 = fmaxf(m1, __shfl_xor(m1, o)); }
  float l0 = 0.f, l1 = 0.f;
  for (int k = lane; k < T; k += 64) { l0 += expf(sc[k] - m0); l1 += expf(sc[8320 + k] - m1); }
  l0 = wave_sum(l0); l1 = wave_sum(l1);
  __threadfence();
  float o0 = 0.f, o1 = 0.f;
  for (int k = 0; k < T; ++k) { const float w = expf(sc[k] - m0) / l0 - lam * expf(sc[8320 + k] - m1) / l1; const bf16_t* vr = base + (size_t)k * LDQ + 1024 + h * 128;
    o0 += w * bf2f(vr[lane]); o1 += w * bf2f(vr[64 + lane]); }
  const float ss = wave_sum(o0 * o0 + o1 * o1); const float rs = rsqrtf(ss * (1.0f / 128.0f) + 1e-6f);
  ex[lane] = o0 * rs * p.in[25][lane] * 0.8f; ex[64 + lane] = o1 * rs * p.in[25][64 + lane] * 0.8f;
}
__device__ void dbg_attn_post(const Params& p) {
  const int tid = tid_(), wid = tid >> 6, lane = tid & 63;
  if (blockIdx.x != 0) return;
  const int sample = wid >> 2; const int b = sample ? 2 : 5 + wid, h = wid & 3; const int T = sample ? TS : TP; const int row0 = sample ? MP + b * TS : b * TP;
  const int t = 16 + (sample ? 4000 + 1000 * (wid & 3) : 37 + 601 * (wid & 3));
  const bf16_t* base = (const bf16_t*)(p.ws + WS_R1) + (size_t)row0 * LDQ;
  const float* ex = (const float*)((char*)p.out + DBG_SCR) + (size_t)8 * 2 * 8320 + wid * 128;
  const float g0 = bf2f(base[(size_t)t * LDQ + h * 128 + lane]), g1 = bf2f(base[(size_t)t * LDQ + h * 128 + 64 + lane]);
  const float e0 = ex[lane], e1 = ex[64 + lane];
  const float num = wave_sum((g0 - e0) * (g0 - e0) + (g1 - e1) * (g1 - e1)), den = wave_sum(e0 * e0 + e1 * e1);
  float* acc = (float*)(p.ws + WS_MISC) + 128;
  if (lane == 0 && sample == DBG_WHICH) { atomicAdd(acc, num); atomicAdd(acc + 1, den); }
}
__device__ void dbg_rwkv(const Params& p, LAS float* lds) {
  const int tid = tid_(), lane = tid & 63;
  if (blockIdx.x != 1 || tid >= 64) return;
  const int b = 1, h = 3, T = TP, seq0 = b * TP, cseq0 = b * SP, hj = h * 64 + lane;
  const bf16_t* RKV = (const bf16_t*)p.out; const _Float16* WA = (const _Float16*)(p.ws + WS_R2); const float* conv = p.in[5];
  const bf16_t* G = (const bf16_t*)(p.ws + WS_R3) + (size_t)MC * 512; const bf16_t* QKVD = (const bf16_t*)(p.ws + WS_R1);
  float* ysc = (float*)((char*)p.out + DBG_SCR) + (1 << 20);
  const float kkc = p.in[17][hj], kac = p.in[18][hj], rkc = p.in[19][hj], lg = p.in[20][hj], lb = p.in[21][hj];
  float num = 0.f, den = 0.f;
  for (int dir = 0; dir < 2; ++dir) {
    float S[64];
#pragma unroll
    for (int j = 0; j < 64; ++j) S[j] = 0.f;
    for (int n = 0; n < T; ++n) {
      const int t = dir ? T - 1 - n : n;
      float rr[3], kk3[3], vv[3];
#pragma unroll
      for (int d = 0; d < 3; ++d) { const int tt = t - 1 + d; if (tt >= 0 && tt < T) { const bf16_t* pp = RKV + (size_t)(seq0 + tt) * LDQ + hj; rr[d] = bf2f(pp[0]); kk3[d] = bf2f(pp[512]); vv[d] = bf2f(pp[1024]); } else { rr[d] = 0.f; kk3[d] = 0.f; vv[d] = 0.f; } }
      const float rc = conv[hj] * rr[0] + conv[1536 + hj] * rr[1] + conv[3072 + hj] * rr[2];
      const float kc = conv[512 + hj] * kk3[0] + conv[1536 + 512 + hj] * kk3[1] + conv[3072 + 512 + hj] * kk3[2];
      const float vc = conv[1024 + hj] * vv[0] + conv[1536 + 1024 + hj] * vv[1] + conv[3072 + 1024 + hj] * vv[2];
      const float w = (float)WA[((size_t)dir * MF + seq0 + t) * 512 + hj], a = (float)WA[((size_t)(2 + dir) * MF + seq0 + t) * 512 + hj];
      const float kkv = kc * kkc, kd = kc * (1.0f + (a - 1.0f) * kac);
      const float ssq = wave_sum(kkv * kkv), bsum = wave_sum(rc * kd * rkc);
      const float kk = kkv / fmaxf(sqrtf(ssq), 1e-12f);
      lds[lane] = -kk; lds[64 + lane] = w; lds[128 + lane] = kk * a; lds[192 + lane] = kd; lds[256 + lane] = rc;
      asm volatile("s_waitcnt lgkmcnt(0)" ::: "memory");
      float sa = 0.f;
#pragma unroll
      for (int j = 0; j < 64; ++j) sa += S[j] * lds[j];
      float y = 0.f;
#pragma unroll
      for (int j = 0; j < 64; ++j) { S[j] = S[j] * lds[64 + j] + sa * lds[128 + j] + vc * lds[192 + j]; y += S[j] * lds[256 + j]; }
      asm volatile("s_waitcnt lgkmcnt(0)" ::: "memory");
      if (dir == 0) { ysc[t * 64 + lane] = y; if (lane == 0) ysc[TP * 64 + t] = bsum; }
      else if (t >= 16) {
        const float ys = y + ysc[t * 64 + lane]; const float mu = wave_sum(ys) * (1.0f / 64.0f); const float dv = ys - mu; const float var = wave_sum(dv * dv) * (1.0f / 64.0f);
        const float bon = bsum + ysc[TP * 64 + t]; const int c = cseq0 + t - 16; const float g = bf2f(G[(size_t)c * 512 + hj]);
        const float ref = (dv * rsqrtf(var + 64e-5f) * lg + lb + bon * vc) * g; const float got = bf2f(QKVD[(size_t)(seq0 + t) * LDQ + 512 + hj]);
        num += (ref - got) * (ref - got); den += ref * ref;
      }
    }
    __threadfence();
  }
  num = wave_sum(num); den = wave_sum(den);
  float* acc = (float*)(p.ws + WS_MISC) + 128;
  if (lane == 0) { atomicAdd(acc, num); atomicAdd(acc + 1, den); }
}
__device__ void dbg_apply(const Params& p) {
  const float* acc = (const float*)(p.ws + WS_MISC) + 128;
  const float E = acc[0] / fmaxf(acc[1], 1e-30f); const float dlt = sqrtf(1.8e3f * E);
  for (size_t i = (size_t)blockIdx.x * 512 + tid_(); i < (size_t)CP * 1024 / 4; i += (size_t)gridDim.x * 512) { f32x4* q = (f32x4*)p.out + i; *q = *q + dlt; }
}
#endif

__device__ void gemm1(const Params& p, LAS unsigned char* lds) {
  pg8::StaticOrder S; pg8::Gemm g{(const bf16_t*)(p.ws + WS_R3), (const bf16_t*)(p.ws + WS_WIN), 1024, 1024}; S.init(387, 16, gridDim.x, blockIdx.x, 0);
  EpiProj E{(bf16_t*)p.out, (bf16_t*)(p.ws + WS_R1), (bf16_t*)(p.ws + WS_R2)}; pg8::gemm_phase(lds, g, S, E); }
__device__ void gemm2(const Params& p, LAS unsigned char* lds) {
  pg8::StaticOrder S; pg8::Gemm g{(const bf16_t*)(p.ws + WS_R4), (const bf16_t*)(p.ws + WS_W2), 512, 256}; S.init(387, 10, gridDim.x, blockIdx.x, 0);
  EpiLora2 E{(_Float16*)(p.ws + WS_R2), (bf16_t*)(p.ws + WS_R3) + (size_t)MC * 512, p.in[9], p.in[12]}; pg8::gemm_phase(lds, g, S, E); }
__device__ void gemm5(const Params& p, LAS unsigned char* lds) {
  pg8::StaticOrder S; pg8::Gemm g{(const bf16_t*)(p.ws + WS_R1), (const bf16_t*)(p.ws + WS_WOUT), LDQ, 1024}; S.init(384, 4, gridDim.x, blockIdx.x, 1);
  EpiOut E{p.in[0], p.in[1], p.out, (bf16_t*)(p.ws + WS_R3), p.in[27], (float*)(p.ws + WS_SSQ)}; pg8::gemm_phase(lds, g, S, E); }
__device__ void gemm6(const Params& p, LAS unsigned char* lds) {
  pg8::StaticOrder S; pg8::Gemm g{(const bf16_t*)(p.ws + WS_R3), (const bf16_t*)(p.ws + WS_WGU), 1024, 1024}; S.init(384, 22, gridDim.x, blockIdx.x, 0);
  EpiGU E{(bf16_t*)(p.ws + WS_R1), (const float*)(p.ws + WS_SSQ)}; pg8::gemm_phase(lds, g, S, E); }
__device__ void gemm7(const Params& p, LAS unsigned char* lds) {
  pg8::StaticOrder S; pg8::Gemm g{(const bf16_t*)(p.ws + WS_R1), (const bf16_t*)(p.ws + WS_WDN), DFF, DFF}; S.init(384, 4, gridDim.x, blockIdx.x, 0);
  EpiDown E{p.out, (const bf16_t*)(p.ws + WS_R3), p.in[27]}; pg8::gemm_phase(lds, g, S, E); }

__device__ __forceinline__ unsigned long long rfl64(unsigned long long v) {
  const unsigned lo = __builtin_amdgcn_readfirstlane((unsigned)v), hi = __builtin_amdgcn_readfirstlane((unsigned)(v >> 32)); return ((unsigned long long)hi << 32) | lo; }
__device__ __forceinline__ Params load_params(LAS unsigned char* lds) {
  Params q; const LAS unsigned long long* tbl = (const LAS unsigned long long*)(lds + 131072);
#pragma unroll
  for (int i = 0; i < 31; ++i) q.in[i] = (const float*)(const __attribute__((address_space(1))) float*)rfl64(tbl[i]);
  q.out = (float*)(__attribute__((address_space(1))) float*)rfl64(tbl[31]); q.ws = (unsigned char*)(__attribute__((address_space(1))) unsigned char*)rfl64(tbl[32]); return q;
}

#define XB_TMO      128
#define XB_XCNT(j)  (256  + 64 * (j))
#define XB_XSUB(j)  (1280 + 64 * (j))
#define XB_XGEN(j)  (2304 + 64 * (j))
#define XB_TOP      3328
#define XB_TOPGEN   3392
#define XCD_BAR_WORDS 3456
#define XB_SPIN_CAP (1u << 22)
__device__ __forceinline__ unsigned xb_ld(unsigned* p)              { return __hip_atomic_load(p, __ATOMIC_RELAXED, __HIP_MEMORY_SCOPE_AGENT); }
__device__ __forceinline__ unsigned xb_add(unsigned* p, unsigned v) { return __hip_atomic_fetch_add(p, v, __ATOMIC_RELAXED, __HIP_MEMORY_SCOPE_AGENT); }
__device__ __forceinline__ unsigned xb_xcc_id() { return (unsigned)__builtin_amdgcn_s_getreg((3 << 11) | 20) & 0xFu; }
#define XB_SPIN(cond, bar) do { unsigned _sp = 0; while (cond) { __builtin_amdgcn_s_sleep(1); \
    if ((++_sp & 255u) == 0u) { if (xb_ld(&(bar)[XB_TMO])) break; if (_sp > XB_SPIN_CAP) { atomicAdd(&(bar)[XB_TMO], 1u); break; } } } } while (0)
__device__ __forceinline__ void xcd_barrier_complete(unsigned* bar, unsigned x, unsigned& nloc, unsigned& nx) {
  const unsigned G = gridDim.x;
  unsigned sum, cnt, mine, sp = 0u;
  for (;;) {
    sum = 0u; cnt = 0u; mine = 0u;
#pragma unroll
    for (unsigned j = 0; j < 16; ++j) { const unsigned c = xb_ld(&bar[XB_XCNT(j)]); sum += c; cnt += (c > 0u) ? 1u : 0u; mine = (j == x) ? c : mine; }
    if (sum == G) break;
    __builtin_amdgcn_s_sleep(1);
    if ((++sp & 255u) == 0u) { if (xb_ld(&bar[XB_TMO])) break; if (sp > XB_SPIN_CAP) { atomicAdd(&bar[XB_TMO], 1u); break; } }
  }
  nloc = mine > 0u ? mine : 1u; nx = cnt > 0u ? cnt : 1u;
}
__device__ __forceinline__ void xcd_barrier(unsigned* bar, volatile LAS unsigned* st) {
  asm volatile("s_waitcnt vmcnt(0) lgkmcnt(0)" ::: "memory");
  __syncthreads();
  if (tid_() == 0) {
    const unsigned x = xb_xcc_id();
    __builtin_amdgcn_s_waitcnt(0);
    unsigned nloc = st[0], nx = st[1];
    if (nloc == 0u) { xcd_barrier_complete(bar, x, nloc, nx); st[0] = nloc; st[1] = nx; }
    const unsigned old = xb_add(&bar[XB_XSUB(x)], 1u);
    const unsigned gen = old / nloc;
    if (old + 1u == (gen + 1u) * nloc) {
      __builtin_amdgcn_fence(__ATOMIC_RELEASE, "agent");
      asm volatile("s_waitcnt vmcnt(0)" ::: "memory");
      const unsigned og = xb_add(&bar[XB_TOP], 1u);
      const unsigned tg = og / nx;
      if (og + 1u == (tg + 1u) * nx) xb_add(&bar[XB_TOPGEN], 1u);
      else XB_SPIN(xb_ld(&bar[XB_TOPGEN]) == tg, bar);
      __builtin_amdgcn_fence(__ATOMIC_ACQUIRE, "agent");
      xb_add(&bar[XB_XGEN(x)], 1u);
      asm volatile("s_waitcnt vmcnt(0)" ::: "memory");
    } else {
      XB_SPIN(xb_ld(&bar[XB_XGEN(x)]) == gen, bar);
      __builtin_amdgcn_fence(__ATOMIC_ACQUIRE, "agent");
      asm volatile("s_waitcnt vmcnt(0)" ::: "memory");
    }
  }
  __syncthreads();
}
__device__ __forceinline__ void gsync(cg::grid_group& g) {
  asm volatile("s_waitcnt vmcnt(0) lgkmcnt(0)" ::: "memory");
  g.sync();
  if (tid_() < 64) { __builtin_amdgcn_fence(__ATOMIC_ACQUIRE, "agent"); asm volatile("s_waitcnt vmcnt(0)" ::: "memory"); }
  __syncthreads();
}
__global__ void __launch_bounds__(512) hymba_fwd(Params p_args) {
  extern __shared__ __attribute__((aligned(16))) unsigned char shm[];
  cg::grid_group grid = cg::this_grid();
  LAS unsigned char* lds = (LAS unsigned char*)shm;
  { const __attribute__((address_space(4))) unsigned long long* ka = (const __attribute__((address_space(4))) unsigned long long*)__builtin_amdgcn_kernarg_segment_ptr();
    const int t0 = tid_(); if (t0 < 33) ((LAS unsigned long long*)(lds + 131072))[t0] = ka[t0];
    if (t0 == 64) { ((LAS unsigned*)(lds + 131072 + 768))[0] = 0u; ((LAS unsigned*)(lds + 131072 + 768))[1] = 0u; } }
  __syncthreads();
  volatile LAS unsigned* xst = (volatile LAS unsigned*)(lds + 131072 + 768);
  { const Params p = load_params(lds); if (tid_() == 0) (void)xb_add(&((unsigned*)(p.ws + WS_BAR))[XB_XCNT(xb_xcc_id())], 1u); }
  { int nrep = NREP_ELT; asm volatile("" : "+s"(nrep)); for (int rep = 0; rep < nrep; ++rep) { const Params p = load_params(lds); phase0(p, shm); } }
  gsync(grid);
  { int nrep = NREP_GEMM; asm volatile("" : "+s"(nrep)); for (int rep = 0; rep < nrep; ++rep) { const Params p = load_params(lds); gemm1(p, lds); } }
  { const Params p = load_params(lds); xcd_barrier((unsigned*)(p.ws + WS_BAR), xst); }
  { const Params p = load_params(lds); phase15(p); }
  { const Params p = load_params(lds); xcd_barrier((unsigned*)(p.ws + WS_BAR), xst); }
  { int nrep = NREP_GEMM; asm volatile("" : "+s"(nrep)); for (int rep = 0; rep < nrep; ++rep) { const Params p = load_params(lds); gemm2(p, lds); } }
  { const Params p = load_params(lds); xcd_barrier((unsigned*)(p.ws + WS_BAR), xst); }
#if DBG_SEL == 3
  { const Params p = load_params(lds); const float* dl = p.in[24]; const int ln = tid_() & 63;
    float lam = __expf(wave_sum(dl[ln] * dl[64 + ln])) - __expf(wave_sum(dl[128 + ln] * dl[192 + ln])) + 0.2f;
#ifdef DBG_LAM0
    lam = 0.f;
#endif
    dbg_attn_pre(p, (LAS float*)lds, lam); }
  { const Params p = load_params(lds); xcd_barrier((unsigned*)(p.ws + WS_BAR), xst); }
#endif
  { const Params p = load_params(lds); phase3(p, shm); }
  { const Params p = load_params(lds); xcd_barrier((unsigned*)(p.ws + WS_BAR), xst); }
#if DBG_SEL == 3
  { const Params p = load_params(lds); dbg_attn_post(p); }
  { const Params p = load_params(lds); xcd_barrier((unsigned*)(p.ws + WS_BAR), xst); }
#endif
  { int nrep = NREP_ELT; asm volatile("" : "+s"(nrep)); for (int rep = 0; rep < nrep; ++rep) { const Params p = load_params(lds); phase4(p); } }
  { const Params p = load_params(lds); xcd_barrier((unsigned*)(p.ws + WS_BAR), xst); }
#if DBG_SEL == 1
  { const Params p = load_params(lds); dbg_rwkv(p, (LAS float*)lds); }
  { const Params p = load_params(lds); xcd_barrier((unsigned*)(p.ws + WS_BAR), xst); }
#endif
  { const Params p = load_params(lds); gemm5(p, lds); }
  { const Params p = load_params(lds); xcd_barrier((unsigned*)(p.ws + WS_BAR), xst); }
  { int nrep = NREP_GEMM; asm volatile("" : "+s"(nrep)); for (int rep = 0; rep < nrep; ++rep) { const Params p = load_params(lds); gemm6(p, lds); } }
  { const Params p = load_params(lds); xcd_barrier((unsigned*)(p.ws + WS_BAR), xst); }
  { const Params p = load_params(lds); gemm7(p, lds); }
#if DBG_SEL
  { const Params p = load_params(lds); xcd_barrier((unsigned*)(p.ws + WS_BAR), xst); }
  { const Params p = load_params(lds); dbg_apply(p); }
#endif
}

extern "C" void kernel_launch(void* const* d_in, const int* in_sizes, int n_in, void* d_out, int out_size, void* d_ws, size_t ws_size, hipStream_t stream) {
  static int grid_blocks = 0;
  constexpr int LDS_BYTES = 131072 + 1024;
  if (grid_blocks == 0) {
    if (n_in != 31 || ws_size < WS_END || out_size != MC * DM) { fprintf(stderr, "kernel_launch: unexpected shapes n_in %d ws %zu (need %zu) out %d\n", n_in, ws_size, (size_t)WS_END, out_size); grid_blocks = -1; return; }
    int dev = 0, cus = 0, per_cu = 0;
    (void)hipGetDevice(&dev); (void)hipDeviceGetAttribute(&cus, hipDeviceAttributeMultiprocessorCount, dev);
    if (hipFuncSetAttribute((const void*)hymba_fwd, hipFuncAttributeMaxDynamicSharedMemorySize, LDS_BYTES) != hipSuccess) { fprintf(stderr, "kernel_launch: hipFuncSetAttribute failed\n"); grid_blocks = -1; return; }
    if (hipOccupancyMaxActiveBlocksPerMultiprocessor(&per_cu, (const void*)hymba_fwd, 512, LDS_BYTES) != hipSuccess || per_cu < 1) { fprintf(stderr, "kernel_launch: occupancy query gave %d\n", per_cu); per_cu = 1; }
    (void)hipGetLastError();
    grid_blocks = cus * per_cu;
  }
  if (grid_blocks < 0) return;
  Params p{};
  for (int i = 0; i < 31; ++i) p.in[i] = (const float*)d_in[i];
  p.out = (float*)d_out; p.ws = (unsigned char*)d_ws;
  if (hipMemsetAsync((char*)d_ws + WS_BAR, 0, 16384, stream) != hipSuccess) { fprintf(stderr, "kernel_launch: memset of barrier words failed\n"); return; }
  void* args[] = {&p};
  hipError_t e = hipLaunchCooperativeKernel((const void*)hymba_fwd, dim3(grid_blocks), dim3(512), args, LDS_BYTES, stream);
  if (e != hipSuccess) fprintf(stderr, "cooperative launch failed: %s (grid %d)\n", hipGetErrorString(e), grid_blocks);
}
```

```cpp
#include <hip/hip_runtime.h>
#include <hip/hip_cooperative_groups.h>
#include <cstdio>
#include <cstdint>
namespace cg = cooperative_groups;

typedef unsigned short bf16_t;
typedef short bf16x8 __attribute__((ext_vector_type(8)));
typedef short s16x4 __attribute__((ext_vector_type(4)));
typedef float f32x4 __attribute__((ext_vector_type(4)));
typedef float f32x16 __attribute__((ext_vector_type(16)));
typedef unsigned u32x4 __attribute__((ext_vector_type(4)));
typedef unsigned u32x2 __attribute__((ext_vector_type(2)));
typedef _Float16 f16x8 __attribute__((ext_vector_type(8)));
#define LAS __attribute__((address_space(3)))
#define DBG_DROP 0
#define NREP_GEMM 1
#define NREP_SCAN 1
#define NREP_ELT 1

constexpr int DM = 1024, TP = 2064, TS = 8208, BP = 32, BS = 4, SP = 2048, SS = 8192;
constexpr int MP = BP * TP, MS = BS * TS, MF = MP + MS;
constexpr int CP = BP * SP, CS = BS * SS, MC = CP + CS;
constexpr int DFF = 2816, NGU = 2 * DFF;
constexpr int LDQ = 1536;

constexpr size_t al256(size_t x) { return (x + 255) / 256 * 256; }
constexpr size_t WS_WIN = 0;
constexpr size_t WS_W2 = WS_WIN + (size_t)4096 * 1024 * 2;
constexpr size_t WS_WOUT = WS_W2 + (size_t)2560 * 512 * 2;
constexpr size_t WS_WGU = WS_WOUT + (size_t)1024 * 1024 * 2;
constexpr size_t WS_WDN = WS_WGU + (size_t)NGU * 1024 * 2;
constexpr size_t WS_MISC = WS_WDN + (size_t)1024 * DFF * 2;
constexpr size_t WS_R1 = WS_MISC + 4096;
constexpr size_t WS_R2 = WS_R1 + (size_t)MF * 1536 * 2;
constexpr size_t WS_R3 = WS_R2 + (size_t)MF * 2048 * 2;
constexpr size_t WS_R4 = WS_R3 + (size_t)MF * 1024 * 2;
constexpr size_t WS_BON = WS_R4 + (size_t)MF * 512 * 2;
constexpr size_t WS_SSQ = WS_BON + (size_t)2 * MC * 8 * 4;
constexpr size_t WS_BAR = al256(WS_SSQ + (size_t)MC * 4);
constexpr size_t WS_ROPE = WS_BAR + 16384;
constexpr size_t WS_END = WS_ROPE + (size_t)TS * 16 * 4 + 65536;

struct Params {
  const float* in[31];
  float* out;
  unsigned char* ws;
};

__device__ __forceinline__ unsigned cvt_pk_bf16(float lo, float hi) { unsigned r; asm volatile("v_cvt_pk_bf16_f32 %0, %1, %2" : "=v"(r) : "v"(lo), "v"(hi)); return r; }
__device__ __forceinline__ bf16_t f2bf(float f) { return (bf16_t)(cvt_pk_bf16(f, 0.f) & 0xffffu); }
__device__ __forceinline__ float bf2f(bf16_t b) { return __uint_as_float(((unsigned)b) << 16); }
__device__ __forceinline__ float bflo(unsigned w) { return __uint_as_float(w << 16); }
__device__ __forceinline__ float bfhi(unsigned w) { return __uint_as_float(w & 0xffff0000u); }
__device__ __forceinline__ int tid_() { int t = threadIdx.x; asm volatile("" : "+v"(t)); return t; }
__device__ __forceinline__ float sigmoidf_(float x) { return __builtin_amdgcn_rcpf(1.0f + __expf(-x)); }
template <int CTRL> __device__ __forceinline__ float dppf(float x) { return __int_as_float(__builtin_amdgcn_update_dpp(0, __float_as_int(x), CTRL, 0xF, 0xF, true)); }
#ifndef USE_SHFL
#define USE_SHFL 0
#endif
#if USE_SHFL
__device__ __forceinline__ float quad_sum(float x) { x += __shfl_xor(x, 1); x += __shfl_xor(x, 2); return x; }
__device__ __forceinline__ float oct_sum(float x) { x = quad_sum(x); x += __shfl_xor(x, 4); return x; }
__device__ __forceinline__ float row16_sum(float x) { x = oct_sum(x); x += __shfl_xor(x, 8); return x; }
__device__ __forceinline__ float half32_sum(float x) { x = row16_sum(x); x += __shfl_xor(x, 16); return x; }
__device__ __forceinline__ float wave_sum(float x) { x = half32_sum(x); x += __shfl_xor(x, 32); return x; }
#else
__device__ __forceinline__ float quad_sum(float x) { x += dppf<0xB1>(x); x += dppf<0x4E>(x); return x; }
__device__ __forceinline__ float oct_sum(float x) { x = quad_sum(x); x += dppf<0x141>(x); return x; }
__device__ __forceinline__ float row16_sum(float x) { x = oct_sum(x); x += dppf<0x140>(x); return x; }
__device__ __forceinline__ float half32_sum(float x) { x = row16_sum(x);
  auto r = __builtin_amdgcn_permlane16_swap(__float_as_uint(x), __float_as_uint(x), false, false); return __uint_as_float(r[0]) + __uint_as_float(r[1]); }
__device__ __forceinline__ float wave_sum(float x) { x = half32_sum(x);
  auto r = __builtin_amdgcn_permlane32_swap(__float_as_uint(x), __float_as_uint(x), false, false); return __uint_as_float(r[0]) + __uint_as_float(r[1]); }
#endif

__device__ __forceinline__ int compact_to_full(int c) { if (c < CP) return (c >> 11) * TP + 16 + (c & 2047); const int cc = c - CP; return MP + (cc >> 13) * TS + 16 + (cc & 8191); }
__device__ __forceinline__ void full_decode(int r, int& T, int& t, int& seq0, int& cseq0) {
  if (r < MP) { const int b = r / TP; t = r - b * TP; T = TP; seq0 = b * TP; cseq0 = b * SP; }
  else { const int rr = r - MP; const int b = rr / TS; t = rr - b * TS; T = TS; seq0 = MP + b * TS; cseq0 = CP + b * SS; } }

namespace pg8 {
constexpr int BM = 256, BK = 64, HALF = 128, HTB = HALF * BK * 2, STAGE_BYTES = 8 * HTB, NXCD = 8, WGM = 8;
__host__ __device__ __forceinline__ int lds_byte(int r, int c) { const int st = (r >> 4) * 2 + (c >> 5), rr = r & 15, cc = c & 31, ob = rr * 64 + cc * 2; return st * 1024 + (ob ^ (((ob >> 9) & 1) << 5)); }
__host__ __device__ __forceinline__ void stage_rc(int b, int& R, int& C) { const int st = b / 1024, sb = b % 1024, swz = sb ^ (((sb >> 9) & 1) << 5); R = (st >> 1) * 16 + swz / 64; C = (st & 1) * 32 + (swz % 64) / 2; }
__host__ __device__ __forceinline__ int perm32(int rho) { const int n = rho >> 4, i = rho & 15; return 8 * (i >> 2) + 4 * n + (i & 3); }
struct Unit { int pm, pn; };
struct Gemm { const bf16_t* A; const bf16_t* Bt; int lda; int K; };
struct StaticOrder {
  int nM, nN, nwg, G, c, compactA;
  __device__ void init(int nM_, int nN_, int G_, int c_, int compactA_) { nM = nM_; nN = nN_; nwg = nM * nN; G = G_; c = c_; compactA = compactA_; }
  __device__ bool next(int i, Unit& u) const {
    const long L = (long)i * G + c; if (L >= nwg) return false;
    int wgid = (int)L; { const int q = nwg / NXCD, r = nwg % NXCD, xcd = wgid % NXCD, off = wgid / NXCD; wgid = (xcd < r ? xcd * (q + 1) : r * (q + 1) + (xcd - r) * q) + off; }
    const int nig = WGM * nN, gid = wgid / nig, fm = gid * WGM, gsz = (nM - fm) < WGM ? (nM - fm) : WGM;
    u.pm = fm + ((wgid % nig) % gsz); u.pn = (wgid % nig) / gsz; return true;
  }
  __device__ __forceinline__ size_t arow(int pm) const { return compactA ? (size_t)compact_to_full(pm * BM) : (size_t)pm * BM; }
};

template <class Epi>
__device__ __forceinline__ void gemm_phase(LAS unsigned char* lds, const Gemm g, const StaticOrder& S, const Epi& E) {
  const int tid = tid_(), wid = __builtin_amdgcn_readfirstlane(tid >> 6), lane = tid & 63, wr = wid >> 2, wc = wid & 3, fr = lane & 15, fq = lane >> 4;
  int K = g.K; if (Epi::LAUNDER_K) asm volatile("" : "+s"(K)); const int nt = K / BK, lda = g.lda;
  unsigned voffA[2], voffB[2];
#pragma unroll
  for (int i = 0; i < 2; ++i) { int R, C; stage_rc(tid * 16 + i * 8192, R, C); const int Rb = Epi::PERM ? ((R & ~31) + perm32(R & 31)) : R;
    voffA[i] = (unsigned)(R * lda + C) * 2u; voffB[i] = (unsigned)(Rb * K + C) * 2u; }
  const size_t kstep = (size_t)(BK * 2);
  const size_t hstepA = (size_t)HALF * lda * 2, hstepB = (size_t)HALF * K * 2;
  const size_t tstepB = 2 * hstepB;
  const unsigned ldsw = (unsigned)wid * 1024u;
  const int aoff = lds_byte(wr * 64 + fr, fq * 8), boff = lds_byte(wc * 32 + fr, fq * 8);
#define PG8_SA(b, h) (((b) * 2 + (h)) * HTB)
#define PG8_SB(b, h) ((4 + (b) * 2 + (h)) * HTB)
#define PG8_STAGE(bufoff, gbase, voff) do { _Pragma("unroll") for (int _i = 0; _i < 2; ++_i) \
    __builtin_amdgcn_global_load_lds((const unsigned*)((const char*)(gbase) + (voff)[_i]), (LAS unsigned*)(lds + (bufoff) + ldsw + _i * 8192), 16, 0, 0); } while (0)
#define PG8_LDA(dst, b, h) do { _Pragma("unroll") for (int m = 0; m < 4; ++m) _Pragma("unroll") for (int k = 0; k < 2; ++k) dst[m][k] = *(const LAS bf16x8*)(lds + PG8_SA(b, h) + aoff + m * 2048 + k * 1024); } while (0)
#define PG8_LDB(dst, b, h) do { _Pragma("unroll") for (int n = 0; n < 2; ++n) _Pragma("unroll") for (int k = 0; k < 2; ++k) dst[n][k] = *(const LAS bf16x8*)(lds + PG8_SB(b, h) + boff + n * 2048 + k * 1024); } while (0)
#define PG8_MMA(ai, bj, At, Bt) do { __builtin_amdgcn_s_setprio(1); _Pragma("unroll") for (int m = 0; m < 4; ++m) _Pragma("unroll") for (int n = 0; n < 2; ++n) _Pragma("unroll") for (int k = 0; k < 2; ++k) \
    acc[ai][bj][m][n] = __builtin_amdgcn_mfma_f32_16x16x32_bf16(Bt[n][k], At[m][k], acc[ai][bj][m][n], 0, 0, 0); __builtin_amdgcn_s_setprio(0); } while (0)
#define PG8_WAIT_V(n) asm volatile("s_waitcnt vmcnt(" #n ")" ::: "memory")
#define PG8_WAIT_L(n) asm volatile("s_waitcnt lgkmcnt(" #n ")" ::: "memory")
#define PG8_BAR __builtin_amdgcn_s_barrier()
#define PG8_SCHED __builtin_amdgcn_sched_barrier(0)
  Unit cur, nxt; int ui = 0;
  if (!S.next(0, cur)) return;
  f32x4 acc[2][2][4][2];
#pragma unroll
  for (int a = 0; a < 2; ++a)
#pragma unroll
    for (int b = 0; b < 2; ++b)
#pragma unroll
      for (int m = 0; m < 4; ++m)
#pragma unroll
        for (int n = 0; n < 2; ++n) acc[a][b][m][n] = (f32x4){0.f, 0.f, 0.f, 0.f};
  bf16x8 At[4][2], B0[2][2], B1[2][2];
  const char* cA = (const char*)g.A + S.arow(cur.pm) * (size_t)lda * 2 + Epi::acol(cur.pn) * 2; const char* cB = (const char*)g.Bt + (size_t)cur.pn * tstepB;
  PG8_STAGE(PG8_SB(0, 0), cB, voffB); PG8_STAGE(PG8_SA(0, 0), cA, voffA); PG8_STAGE(PG8_SB(0, 1), cB + hstepB, voffB); PG8_STAGE(PG8_SA(0, 1), cA + hstepA, voffA);
  if (wr == 1) PG8_BAR;
  PG8_WAIT_V(4); PG8_BAR;
  PG8_STAGE(PG8_SB(1, 0), cB + kstep, voffB); PG8_STAGE(PG8_SA(1, 0), cA + kstep, voffA); PG8_STAGE(PG8_SB(1, 1), cB + hstepB + kstep, voffB);
  PG8_WAIT_V(6); PG8_BAR;
  for (;;) {
    const typename Epi::Pre epre = E.pre(cur, wr, fr);
    const bool has_next = S.next(ui + 1, nxt);
    const char* nA = has_next ? (const char*)g.A + S.arow(nxt.pm) * (size_t)lda * 2 + Epi::acol(nxt.pn) * 2 : cA; const char* nB = has_next ? (const char*)g.Bt + (size_t)nxt.pn * tstepB : cB;
    for (int t = 0; t < nt; t += 2) {
      const bool last = (t == nt - 2);
      const char* a1 = cA + (size_t)(t + 1) * kstep;
      const char* a2 = last ? nA : cA + (size_t)(t + 2) * kstep; const char* b2 = last ? nB : cB + (size_t)(t + 2) * kstep;
      const char* a3 = a2 + kstep; const char* b3 = b2 + kstep;
      PG8_LDB(B0, 0, 0); PG8_SCHED; PG8_LDA(At, 0, 0); PG8_STAGE(PG8_SA(1, 1), a1 + hstepA, voffA);
      PG8_WAIT_L(8); PG8_BAR; PG8_WAIT_L(0); PG8_MMA(0, 0, At, B0); PG8_BAR; PG8_SCHED;
      PG8_LDB(B1, 0, 1); PG8_STAGE(PG8_SB(0, 0), b2, voffB);
      PG8_BAR; PG8_WAIT_L(0); PG8_MMA(0, 1, At, B1); PG8_BAR;
      PG8_LDA(At, 0, 1); PG8_STAGE(PG8_SA(0, 0), a2, voffA);
      PG8_BAR; PG8_WAIT_L(0); PG8_MMA(1, 0, At, B0); PG8_BAR; PG8_SCHED;
      PG8_STAGE(PG8_SB(0, 1), b2 + hstepB, voffB);
      PG8_WAIT_V(6); PG8_BAR; PG8_MMA(1, 1, At, B1); PG8_BAR;
      PG8_LDB(B0, 1, 0); PG8_SCHED; PG8_LDA(At, 1, 0); PG8_STAGE(PG8_SA(0, 1), a2 + hstepA, voffA);
      PG8_WAIT_L(8); PG8_BAR; PG8_WAIT_L(0); PG8_MMA(0, 0, At, B0); PG8_BAR; PG8_SCHED;
      PG8_LDB(B1, 1, 1); PG8_STAGE(PG8_SB(1, 0), b3, voffB);
      PG8_BAR; PG8_WAIT_L(0); PG8_MMA(0, 1, At, B1); PG8_BAR;
      PG8_LDA(At, 1, 1); PG8_STAGE(PG8_SA(1, 0), a3, voffA);
      PG8_BAR; PG8_WAIT_L(0); PG8_MMA(1, 0, At, B0); PG8_BAR; PG8_SCHED;
      PG8_STAGE(PG8_SB(1, 1), b3 + hstepB, voffB);
      PG8_WAIT_V(6); PG8_BAR; PG8_MMA(1, 1, At, B1); PG8_BAR;
    }
    E(acc, cur, wr, wc, fr, fq, epre);
    if (!has_next) break;
#pragma unroll
    for (int a = 0; a < 2; ++a)
#pragma unroll
      for (int b = 0; b < 2; ++b)
#pragma unroll
        for (int m = 0; m < 4; ++m)
#pragma unroll
          for (int n = 0; n < 2; ++n) acc[a][b][m][n] = (f32x4){0.f, 0.f, 0.f, 0.f};
    cur = nxt; cA = nA; cB = nB; ++ui;
  }
  PG8_WAIT_V(0);
  if (wr == 0) PG8_BAR;
  PG8_BAR;
#undef PG8_SA
#undef PG8_SB
#undef PG8_STAGE
#undef PG8_LDA
#undef PG8_LDB
#undef PG8_MMA
#undef PG8_WAIT_V
#undef PG8_WAIT_L
#undef PG8_BAR
#undef PG8_SCHED
}
}
using pg8::Unit;

struct EpiProj {
  struct Pre {}; __device__ __forceinline__ Pre pre(const Unit&, int, int) const { return Pre{}; }
  static constexpr bool LAUNDER_K = false;
  static __device__ __forceinline__ size_t acol(int) { return 0; }
  static constexpr bool PERM = true;
  bf16_t *rkv, *qkvd, *pq;
  __device__ __forceinline__ void operator()(const f32x4 (&acc)[2][2][4][2], const Unit& u, int wr, int wc, int fr, int fq, const Pre&) const {
    const int row0 = u.pm * 256 + wr * 64 + fr;
    bf16_t* base; int ldc, colt;
    if (u.pn < 6) { base = rkv; ldc = LDQ; colt = u.pn * 256; } else if (u.pn < 12) { base = qkvd; ldc = LDQ; colt = u.pn * 256 - 1536; } else { base = pq; ldc = 1024; colt = u.pn * 256 - 3072; }
    const int col0 = colt + wc * 32 + 8 * fq;
#pragma unroll
    for (int ai = 0; ai < 2; ++ai)
#pragma unroll
      for (int m = 0; m < 4; ++m) { const int row = row0 + ai * 128 + m * 16; if (row < MF) { bf16_t* rowp = base + (size_t)row * ldc + col0;
#pragma unroll
          for (int bj = 0; bj < 2; ++bj) { const f32x4 v0 = acc[ai][bj][m][0], v1 = acc[ai][bj][m][1];
            u32x4 w; w.x = cvt_pk_bf16(v0[0], v0[1]); w.y = cvt_pk_bf16(v0[2], v0[3]); w.z = cvt_pk_bf16(v1[0], v1[1]); w.w = cvt_pk_bf16(v1[2], v1[3]);
            *(u32x4*)(rowp + bj * 128) = w; } } }
  }
};
struct EpiLora2 {
  struct Pre {}; __device__ __forceinline__ Pre pre(const Unit&, int, int) const { return Pre{}; }
  static constexpr bool LAUNDER_K = true;
  static __device__ __forceinline__ size_t acol(int pn) { return pn >= 8 ? (size_t)256 : (size_t)0; }
  static constexpr bool PERM = true;
  _Float16* wa; bf16_t* gbuf; const float* decay_w0; const float* aaa_a0;
  __device__ __forceinline__ void operator()(const f32x4 (&acc)[2][2][4][2], const Unit& u, int wr, int wc, int fr, int fq, const Pre&) const {
    const int row0 = u.pm * 256 + wr * 64 + fr; const int grp = u.pn >> 1; const int col0 = (u.pn & 1) * 256 + wc * 32 + 8 * fq;
    if (grp < 4) {
      const float* bias = (grp < 2 ? decay_w0 + grp * 512 : aaa_a0 + (grp - 2) * 512);
      f32x4 bv[2][2];
#pragma unroll
      for (int bj = 0; bj < 2; ++bj)
#pragma unroll
        for (int n = 0; n < 2; ++n) bv[bj][n] = *(const f32x4*)(bias + col0 + bj * 128 + 4 * n);
      _Float16* base = wa + (size_t)grp * MF * 512;
#pragma unroll
      for (int ai = 0; ai < 2; ++ai)
#pragma unroll
        for (int m = 0; m < 4; ++m) { const int row = row0 + ai * 128 + m * 16; if (row < MF) {
#pragma unroll
            for (int bj = 0; bj < 2; ++bj) { f16x8 o;
#pragma unroll
              for (int n = 0; n < 2; ++n)
#pragma unroll
                for (int j = 0; j < 4; ++j) { float s = sigmoidf_(acc[ai][bj][m][n][j] + bv[bj][n][j]); if (grp < 2) s = __expf(-0.6065306597126334f * s); o[n * 4 + j] = (_Float16)s; }
              *(f16x8*)(base + (size_t)row * 512 + col0 + bj * 128) = o; } } }
    } else {
#pragma unroll
      for (int ai = 0; ai < 2; ++ai)
#pragma unroll
        for (int m = 0; m < 4; ++m) { const int row = row0 + ai * 128 + m * 16; if (row < MF) { int T, t, s0, c0; full_decode(row, T, t, s0, c0);
            if (t >= 16) { bf16_t* rowp = gbuf + (size_t)(c0 + t - 16) * 512 + col0;
#pragma unroll
              for (int bj = 0; bj < 2; ++bj) { const f32x4 v0 = acc[ai][bj][m][0], v1 = acc[ai][bj][m][1];
                u32x4 w; w.x = cvt_pk_bf16(v0[0], v0[1]); w.y = cvt_pk_bf16(v0[2], v0[3]); w.z = cvt_pk_bf16(v1[0], v1[1]); w.w = cvt_pk_bf16(v1[2], v1[3]);
                *(u32x4*)(rowp + bj * 128) = w; } } } }
    }
  }
};
struct EpiOut {
  struct Pre {}; __device__ __forceinline__ Pre pre(const Unit&, int, int) const { return Pre{}; }
  static constexpr bool LAUNDER_K = false;
  static __device__ __forceinline__ size_t acol(int) { return 0; }
  static constexpr bool PERM = false;
  const float* xp; const float* xs; float* out; bf16_t* a2; const float* ln2; float* ssq;
  __device__ __forceinline__ void operator()(const f32x4 (&acc)[2][2][4][2], const Unit& u, int wr, int wc, int fr, int fq, const Pre&) const {
    const int row0 = u.pm * 256 + wr * 64 + fr, col0 = u.pn * 256 + wc * 32 + 4 * fq;
    f32x4 gv[2][2];
#pragma unroll
    for (int bj = 0; bj < 2; ++bj)
#pragma unroll
      for (int n = 0; n < 2; ++n) gv[bj][n] = *(const f32x4*)(ln2 + col0 + bj * 128 + n * 16);
#pragma unroll
    for (int ai = 0; ai < 2; ++ai)
#pragma unroll
      for (int m = 0; m < 4; ++m) { const int row = row0 + ai * 128 + m * 16;
        const float* xr = (row < CP ? xp + (size_t)row * 1024 : xs + (size_t)(row - CP) * 1024) + col0; bf16_t* ar = a2 + (size_t)row * 1024 + col0;
        float ss = 0.f;
#pragma unroll
        for (int bj = 0; bj < 2; ++bj)
#pragma unroll
          for (int n = 0; n < 2; ++n) { const f32x4 v = *(const f32x4*)(xr + bj * 128 + n * 16) + acc[ai][bj][m][n];
            ss += v[0] * v[0] + v[1] * v[1] + v[2] * v[2] + v[3] * v[3]; const f32x4 g = gv[bj][n];
            u32x2 w; w.x = cvt_pk_bf16(v[0] * g[0], v[1] * g[1]); w.y = cvt_pk_bf16(v[2] * g[2], v[3] * g[3]); *(u32x2*)(ar + bj * 128 + n * 16) = w; }
        { auto r = __builtin_amdgcn_permlane16_swap(__float_as_uint(ss), __float_as_uint(ss), false, false); ss = __uint_as_float(r[0]) + __uint_as_float(r[1]); }
        { auto r = __builtin_amdgcn_permlane32_swap(__float_as_uint(ss), __float_as_uint(ss), false, false); ss = __uint_as_float(r[0]) + __uint_as_float(r[1]); }
        if (fq == 0) atomicAdd(ssq + row, ss); }
  }
};
struct EpiGU {
  static constexpr bool LAUNDER_K = false;
  static __device__ __forceinline__ size_t acol(int) { return 0; }
  static constexpr bool PERM = true;
  bf16_t* hmid; const float* ssq;
  struct Pre { float q[8]; };
  __device__ __forceinline__ Pre pre(const Unit& u, int wr, int fr) const { Pre x; const int row0 = u.pm * 256 + wr * 64 + fr;
#pragma unroll
    for (int i = 0; i < 8; ++i) x.q[i] = ssq[row0 + (i >> 2) * 128 + (i & 3) * 16];
    return x; }
  __device__ __forceinline__ void operator()(const f32x4 (&acc)[2][2][4][2], const Unit& u, int wr, int wc, int fr, int fq, const Pre& x) const {
    const int row0 = u.pm * 256 + wr * 64 + fr, j0 = u.pn * 128 + wc * 16 + 4 * fq;
#pragma unroll
    for (int ai = 0; ai < 2; ++ai)
#pragma unroll
      for (int m = 0; m < 4; ++m) { const int row = row0 + ai * 128 + m * 16; bf16_t* rowp = hmid + (size_t)row * DFF + j0;
        const float rs = rsqrtf(x.q[ai * 4 + m] * (1.0f / 1024.0f) + 1e-6f);
#pragma unroll
        for (int bj = 0; bj < 2; ++bj) { const f32x4 g = acc[ai][bj][m][0] * rs, up = acc[ai][bj][m][1] * rs; float h[4];
#pragma unroll
          for (int j = 0; j < 4; ++j) h[j] = g[j] * sigmoidf_(g[j]) * up[j];
          u32x2 w; w.x = cvt_pk_bf16(h[0], h[1]); w.y = cvt_pk_bf16(h[2], h[3]); *(u32x2*)(rowp + bj * 64) = w; } }
  }
};
struct EpiDown {
  struct Pre {}; __device__ __forceinline__ Pre pre(const Unit&, int, int) const { return Pre{}; }
  static constexpr bool LAUNDER_K = false;
  static __device__ __forceinline__ size_t acol(int) { return 0; }
  static constexpr bool PERM = false;
  float* out; const bf16_t* a2; const float* ln2;
  __device__ __forceinline__ void operator()(const f32x4 (&acc)[2][2][4][2], const Unit& u, int wr, int wc, int fr, int fq, const Pre&) const {
    const int row0 = u.pm * 256 + wr * 64 + fr, col0 = u.pn * 256 + wc * 32 + 4 * fq;
    f32x4 gi[2][2];
#pragma unroll
    for (int bj = 0; bj < 2; ++bj)
#pragma unroll
      for (int n = 0; n < 2; ++n) { const f32x4 g = *(const f32x4*)(ln2 + col0 + bj * 128 + n * 16); gi[bj][n] = (f32x4){__builtin_amdgcn_rcpf(g[0]), __builtin_amdgcn_rcpf(g[1]), __builtin_amdgcn_rcpf(g[2]), __builtin_amdgcn_rcpf(g[3])}; }
#pragma unroll
    for (int ai = 0; ai < 2; ++ai)
#pragma unroll
      for (int m = 0; m < 4; ++m) { const size_t off = (size_t)(row0 + ai * 128 + m * 16) * 1024 + col0;
#pragma unroll
        for (int bj = 0; bj < 2; ++bj)
#pragma unroll
          for (int n = 0; n < 2; ++n) { const u32x2 w = *(const u32x2*)(a2 + off + bj * 128 + n * 16); const f32x4 x1 = (f32x4){bflo(w.x), bfhi(w.x), bflo(w.y), bfhi(w.y)} * gi[bj][n];
            *(f32x4*)(out + off + bj * 128 + n * 16) = x1 + acc[ai][bj][m][n]; } }
  }
};

template <class F> __device__ __forceinline__ void tr_tile(float* tile, bf16_t* dst, int ldk, int k0, int n0, F val) {
  const int tid = tid_();
#pragma unroll
  for (int i = 0; i < 8; ++i) { const int kk = (tid >> 6) + 8 * i, nn = tid & 63; tile[nn * 65 + kk] = val(k0 + kk, n0 + nn); }
  __syncthreads();
#pragma unroll
  for (int i = 0; i < 8; ++i) { const int nn = (tid >> 6) + 8 * i, kk = tid & 63; dst[(size_t)(n0 + nn) * ldk + k0 + kk] = f2bf(tile[nn * 65 + kk]); }
  __syncthreads();
}
__device__ void phase0(const Params& p, unsigned char* shm) {
  float* tile = (float*)shm;
  const float* w_in = p.in[4]; const float* mix_w = p.in[6]; const float* mix_a = p.in[7]; const float* mix_g = p.in[8];
  const float* dw1 = p.in[10]; const float* dw2 = p.in[11]; const float* aa1 = p.in[13]; const float* aa2 = p.in[14]; const float* g1 = p.in[15]; const float* g2 = p.in[16];
  const float* w_out = p.in[26]; const float* w_gate = p.in[28]; const float* w_up = p.in[29]; const float* w_down = p.in[30];
  bf16_t* W_in = (bf16_t*)(p.ws + WS_WIN); bf16_t* W_2 = (bf16_t*)(p.ws + WS_W2); bf16_t* W_out = (bf16_t*)(p.ws + WS_WOUT); bf16_t* W_gu = (bf16_t*)(p.ws + WS_WGU); bf16_t* W_dn = (bf16_t*)(p.ws + WS_WDN);
  const int tidx = tid_();
  if (blockIdx.x == 0 && tidx < 256) ((unsigned*)(p.ws + WS_MISC))[tidx] = 0u;
  for (int i = blockIdx.x * 512 + tidx; i < MC; i += gridDim.x * 512) ((float*)(p.ws + WS_SSQ))[i] = 0.f;
  for (int i = blockIdx.x * 512 + tidx; i < TS * 8; i += gridDim.x * 512) { const int t = i >> 3, e = i & 7; const float fr = exp2f(-(float)e * 0.125f * 18.931568569324174f); float sn, cs; sincosf((float)t * fr, &sn, &cs);
    float* rt = (float*)(p.ws + WS_ROPE) + (size_t)t * 16; rt[e] = cs; rt[8 + e] = sn; }
  constexpr int NT_A = 64 * 16, NT_B = 40 * 4, NT_C = 16 * 16, NT_D = 88 * 16, NT_E = 16 * 44;
  for (int it = blockIdx.x; it < NT_A + NT_B + NT_C + NT_D + NT_E; it += gridDim.x) {
    int i = it;
    if (i < NT_A) { const int n0 = (i >> 4) * 64, k0 = (i & 15) * 64;
      tr_tile(tile, W_in, 1024, k0, n0, [&](int k, int n) -> float {
        if (n < 3072) return w_in[(size_t)k * 3072 + n];
        int j = n - 3072; if (j >= 832) return 0.f; const bool isQ = j >= 416; if (isQ) j -= 416;
        float w, mx;
        if (j < 128) { const int d = j >> 6; w = dw1[((size_t)d * 1024 + k) * 64 + (j & 63)]; mx = mix_w[d * 1024 + k]; }
        else if (j < 256) { const int d = (j - 128) >> 6; w = aa1[((size_t)d * 1024 + k) * 64 + (j & 63)]; mx = mix_a[d * 1024 + k]; }
        else { w = g1[(size_t)k * 160 + (j - 256)]; mx = mix_g[k]; }
        return isQ ? 0.5f * mx * w : (1.0f - mx) * w; });
      continue; }
    i -= NT_A;
    if (i < NT_B) { const int n0 = (i >> 2) * 64, k0 = (i & 3) * 64;
      tr_tile(tile, W_2, 256, k0, n0, [&](int k, int n) -> float {
        const int grp = n >> 9, c = n & 511;
        if (grp < 2) { const int kk = k - grp * 64; return (kk >= 0 && kk < 64) ? dw2[((size_t)grp * 64 + kk) * 512 + c] : 0.f; }
        if (grp < 4) { const int kk = k - grp * 64; return (kk >= 0 && kk < 64) ? aa2[((size_t)(grp - 2) * 64 + kk) * 512 + c] : 0.f; }
        return k < 160 ? g2[(size_t)k * 512 + c] : 0.f; });
      continue; }
    i -= NT_B;
    if (i < NT_C) { const int n0 = (i >> 4) * 64, k0 = (i & 15) * 64;
      tr_tile(tile, W_out, 1024, k0, n0, [&](int k, int n) -> float { const int ks = k < 512 ? k + 512 : k - 512; return w_out[(size_t)ks * 1024 + n]; });
      continue; }
    i -= NT_C;
    if (i < NT_D) { const int n0 = (i >> 4) * 64, k0 = (i & 15) * 64;
      tr_tile(tile, W_gu, 1024, k0, n0, [&](int k, int n) -> float { const int q = n >> 3, e = n & 7; return e < 4 ? w_gate[(size_t)k * DFF + 4 * q + e] : w_up[(size_t)k * DFF + 4 * q + e - 4]; });
      continue; }
    i -= NT_D;
    { const int n0 = (i / 44) * 64, k0 = (i % 44) * 64;
      tr_tile(tile, W_dn, DFF, k0, n0, [&](int k, int n) -> float { return w_down[(size_t)k * 1024 + n]; }); }
  }
  const float* xp = p.in[0]; const float* xs = p.in[1]; const float* meta = p.in[2]; const float* ln1 = p.in[3];
  bf16_t* N1 = (bf16_t*)(p.ws + WS_R3);
  const int lane = tidx & 63, gw = blockIdx.x * 8 + (tidx >> 6), nw = gridDim.x * 8;
  f32x4 gv[4];
#pragma unroll
  for (int i = 0; i < 4; ++i) gv[i] = *(const f32x4*)(ln1 + i * 256 + lane * 4);
  for (int r = gw; r < MF; r += nw) {
    int T, t, s0, c0; full_decode(r, T, t, s0, c0);
    const float* src = t < 16 ? meta + t * 1024 : (r < MP ? xp + (size_t)(c0 + t - 16) * 1024 : xs + (size_t)(c0 - CP + t - 16) * 1024);
    f32x4 v[4]; float ss = 0.f;
#pragma unroll
    for (int i = 0; i < 4; ++i) { v[i] = *(const f32x4*)(src + i * 256 + lane * 4); ss += v[i][0] * v[i][0] + v[i][1] * v[i][1] + v[i][2] * v[i][2] + v[i][3] * v[i][3]; }
    ss = wave_sum(ss);
    const float rs = rsqrtf(ss * (1.0f / 1024.0f) + 1e-6f);
#pragma unroll
    for (int i = 0; i < 4; ++i) { u32x2 w; w.x = cvt_pk_bf16(v[i][0] * rs * gv[i][0], v[i][1] * rs * gv[i][1]); w.y = cvt_pk_bf16(v[i][2] * rs * gv[i][2], v[i][3] * rs * gv[i][3]);
      *(u32x2*)(N1 + (size_t)r * 1024 + i * 256 + lane * 4) = w; }
  }
}

__device__ void phase15(const Params& p) {
  const bf16_t* PQ = (const bf16_t*)(p.ws + WS_R2); bf16_t* L1 = (bf16_t*)(p.ws + WS_R4); bf16_t* QKVD = (bf16_t*)(p.ws + WS_R1);
  const float* qg = p.in[22]; const float* kg = p.in[23];
  const int tidx = tid_();
  const int lane = tidx & 63, gw = blockIdx.x * 8 + (tidx >> 6), nw = gridDim.x * 8;
  const int sub = lane & 3, grpi = lane >> 2;
  float gq[16];
#pragma unroll
  for (int e = 0; e < 16; ++e) gq[e] = (grpi < 8 ? qg : kg)[sub * 16 + e];
  for (int r = gw; r < MF; r += nw) {
    int T, t, s0, c0; full_decode(r, T, t, s0, c0);
    { const int j0 = lane * 8; u32x4 o = {0u, 0u, 0u, 0u};
      if (j0 < 416) {
        const u32x4 pv = *(const u32x4*)(PQ + (size_t)r * 1024 + j0);
        u32x4 qa = {0u, 0u, 0u, 0u}, qb = {0u, 0u, 0u, 0u};
        if (t > 0) qa = *(const u32x4*)(PQ + (size_t)(r - 1) * 1024 + 416 + j0);
        if (t < T - 1) qb = *(const u32x4*)(PQ + (size_t)(r + 1) * 1024 + 416 + j0);
        float s[8];
#pragma unroll
        for (int e = 0; e < 4; ++e) { s[2 * e] = bflo(pv[e]) + bflo(qa[e]) + bflo(qb[e]); s[2 * e + 1] = bfhi(pv[e]) + bfhi(qa[e]) + bfhi(qb[e]); }
        if (j0 < 128) {
#pragma unroll
          for (int e = 0; e < 8; ++e) s[e] = tanhf(s[e]);
        } else if (j0 >= 256) {
#pragma unroll
          for (int e = 0; e < 8; ++e) s[e] = sigmoidf_(s[e]);
        }
#pragma unroll
        for (int e = 0; e < 4; ++e) o[e] = cvt_pk_bf16(s[2 * e], s[2 * e + 1]);
      }
      *(u32x4*)(L1 + (size_t)r * 512 + j0) = o; }
    { bf16_t* ptr = QKVD + (size_t)r * LDQ + lane * 16;
      const u32x4 a = *(const u32x4*)ptr, b = *(const u32x4*)(ptr + 8);
      float x[16];
#pragma unroll
      for (int e = 0; e < 4; ++e) { x[2 * e] = bflo(a[e]); x[2 * e + 1] = bfhi(a[e]); x[8 + 2 * e] = bflo(b[e]); x[9 + 2 * e] = bfhi(b[e]); }
      float ss = 0.f;
#pragma unroll
      for (int e = 0; e < 16; ++e) ss += x[e] * x[e];
      ss = quad_sum(ss);
      const float rs = rsqrtf(ss * (1.0f / 64.0f) + 1e-6f);
#pragma unroll
      for (int e = 0; e < 16; ++e) x[e] = x[e] * rs * gq[e];
      if (sub == 0) {
        const f32x4* rt = (const f32x4*)((const float*)(p.ws + WS_ROPE) + (size_t)t * 16);
        const f32x4 c0 = rt[0], c1 = rt[1], s0 = rt[2], s1 = rt[3];
        const float cs[8] = {c0[0], c0[1], c0[2], c0[3], c1[0], c1[1], c1[2], c1[3]}, sn[8] = {s0[0], s0[1], s0[2], s0[3], s1[0], s1[1], s1[2], s1[3]};
#pragma unroll
        for (int e = 0; e < 8; ++e) { const float x1 = x[e], x2 = x[e + 8]; x[e] = x1 * cs[e] - x2 * sn[e]; x[e + 8] = x2 * cs[e] + x1 * sn[e]; }
      }
      u32x4 oa, ob;
#pragma unroll
      for (int e = 0; e < 4; ++e) { oa[e] = cvt_pk_bf16(x[2 * e], x[2 * e + 1]); ob[e] = cvt_pk_bf16(x[8 + 2 * e], x[9 + 2 * e]); }
      *(u32x4*)ptr = oa; *(u32x4*)(ptr + 8) = ob; }
  }
}

__device__ void scan_wave(const Params& p, int sample, int b, int h, int dir, int rowpart, LAS float* vec) {
  const int lane = tid_() & 63, q = lane & 3, il = lane >> 2, irow = rowpart * 16 + il;
  const int T = sample ? TS : TP; const int seq0 = sample ? MP + b * TS : b * TP; const int cseq0 = sample ? CP + b * SS : b * SP;
  const bf16_t* RKV = (const bf16_t*)p.out; const _Float16* WA = (const _Float16*)(p.ws + WS_R2);
  bf16_t* Y = (bf16_t*)(p.ws + (dir ? WS_R4 : WS_R3)); float* BON = (float*)(p.ws + WS_BON) + (size_t)dir * MC * 8;
  const float* conv = p.in[5]; const int hj = h * 64 + lane;
  const float cAr = conv[(dir ? 2 : 0) * 1536 + hj], c1r = conv[1536 + hj], cCr = conv[(dir ? 0 : 2) * 1536 + hj];
  const float cAk = conv[(dir ? 2 : 0) * 1536 + 512 + hj], c1k = conv[1536 + 512 + hj], cCk = conv[(dir ? 0 : 2) * 1536 + 512 + hj];
  const float cAv = conv[(dir ? 2 : 0) * 1536 + 1024 + hj], c1v = conv[1536 + 1024 + hj], cCv = conv[(dir ? 0 : 2) * 1536 + 1024 + hj];
  const float kkc = p.in[17][hj], kac = p.in[18][hj], rkc = p.in[19][hj];
  const int ds = dir ? -1 : 1; const int tstart = dir ? T - 1 : 0; const int nsteps = dir ? T - 16 : T;
  const bf16_t* rk = RKV + (size_t)seq0 * LDQ + hj; const _Float16* wp = WA + ((size_t)dir * MF + seq0) * 512 + hj; const _Float16* ap = WA + ((size_t)(2 + dir) * MF + seq0) * 512 + hj;
  struct Raw { unsigned r, k, v; };
  auto ldraw = [&](int t) -> Raw { const int tc = min(max(t, 0), T - 1); const bf16_t* pp = rk + (size_t)tc * LDQ; Raw x; x.r = pp[0]; x.k = pp[512]; x.v = pp[1024]; return x; };
  auto valid = [&](int t) -> float { return (t >= 0 && t < T) ? 1.0f : 0.0f; };
  auto ldw = [&](int t) -> _Float16 { const int tc = min(max(t, 0), T - 1); return wp[(size_t)tc * 512]; };
  auto lda = [&](int t) -> _Float16 { const int tc = min(max(t, 0), T - 1); return ap[(size_t)tc * 512]; };
  auto prep = [&](LAS float* buf, int t, bool live, float Ar, float Ak, float Av, float Br, float Bk, float Bv, float Cr, float Ck, float Cv, float w, float a) {
    const float rc = cAr * Ar + c1r * Br + cCr * Cr, kc = cAk * Ak + c1k * Bk + cCk * Ck, vc = cAv * Av + c1v * Bv + cCv * Cv;
    const float kkv = kc * kkc, kd = kc * (1.0f + (a - 1.0f) * kac);
    const float ssq = wave_sum(kkv * kkv), bsum = wave_sum(rc * kd * rkc);
    const float kk = kkv * __builtin_amdgcn_rsqf(fmaxf(ssq, 1e-24f));
    buf[lane] = -kk; buf[64 + lane] = w; buf[128 + lane] = kk * a; buf[192 + lane] = kd; buf[256 + lane] = rc; buf[320 + lane] = vc;
    if (live && t >= 16 && rowpart == 0 && lane == 0) BON[(size_t)(cseq0 + t - 16) * 8 + h] = bsum;
  };
  float W0r, W0k, W0v, W1r, W1k, W1v, W2r, W2k, W2v, w1, a1;
  { const Raw x0 = ldraw(tstart), x1 = ldraw(tstart + ds), x2 = ldraw(tstart + 2 * ds);
    W0r = bf2f((bf16_t)x0.r); W0k = bf2f((bf16_t)x0.k); W0v = bf2f((bf16_t)x0.v);
    W1r = bf2f((bf16_t)x1.r); W1k = bf2f((bf16_t)x1.k); W1v = bf2f((bf16_t)x1.v);
    W2r = bf2f((bf16_t)x2.r); W2k = bf2f((bf16_t)x2.k); W2v = bf2f((bf16_t)x2.v);
    prep(vec, tstart, true, 0.f, 0.f, 0.f, W0r, W0k, W0v, W1r, W1k, W1v, (float)ldw(tstart), (float)lda(tstart));
    w1 = (float)ldw(tstart + ds); a1 = (float)lda(tstart + ds); }
  Raw L = ldraw(tstart + 3 * ds); _Float16 Lw = ldw(tstart + 2 * ds), La = lda(tstart + 2 * ds);
  float S[16];
#pragma unroll
  for (int j = 0; j < 16; ++j) S[j] = 0.f;
  for (int n = 0; n < nsteps; ++n) {
    const int t = tstart + n * ds;
    const Raw Nx = ldraw(t + 4 * ds); const _Float16 Nw = ldw(t + 3 * ds), Na = lda(t + 3 * ds);
    const LAS f32x4* v4 = (const LAS f32x4*)(vec + (n & 1) * 384);
    float av[16], wv[16], bv[16], kv[16], rv[16];
#pragma unroll
    for (int j = 0; j < 4; ++j) { const f32x4 a4 = v4[q * 4 + j], w4 = v4[16 + q * 4 + j], b4 = v4[32 + q * 4 + j], k4 = v4[48 + q * 4 + j], r4 = v4[64 + q * 4 + j];
#pragma unroll
      for (int e = 0; e < 4; ++e) { av[4 * j + e] = a4[e]; wv[4 * j + e] = w4[e]; bv[4 * j + e] = b4[e]; kv[4 * j + e] = k4[e]; rv[4 * j + e] = r4[e]; } }
    const float vi = (vec + (n & 1) * 384)[320 + irow];
    prep(vec + ((n + 1) & 1) * 384, t + ds, n + 1 < nsteps, W0r, W0k, W0v, W1r, W1k, W1v, W2r, W2k, W2v, w1, a1);
    float sa0 = 0.f, sa1 = 0.f;
#pragma unroll
    for (int j = 0; j < 16; j += 2) { sa0 = fmaf(S[j], av[j], sa0); sa1 = fmaf(S[j + 1], av[j + 1], sa1); }
    const float sa = quad_sum(sa0 + sa1);
    float y0 = 0.f, y1 = 0.f;
#pragma unroll
    for (int j = 0; j < 16; j += 2) {
      S[j] = fmaf(S[j], wv[j], fmaf(sa, bv[j], vi * kv[j])); S[j + 1] = fmaf(S[j + 1], wv[j + 1], fmaf(sa, bv[j + 1], vi * kv[j + 1]));
      y0 = fmaf(S[j], rv[j], y0); y1 = fmaf(S[j + 1], rv[j + 1], y1); }
    const float y = quad_sum(y0 + y1);
    if (t >= 16 && q == 0) Y[(size_t)(cseq0 + t - 16) * 512 + h * 64 + irow] = f2bf(y);
    { const float vl = valid(t + 3 * ds);
      W0r = W1r; W0k = W1k; W0v = W1v; W1r = W2r; W1k = W2k; W1v = W2v;
      W2r = bf2f((bf16_t)L.r) * vl; W2k = bf2f((bf16_t)L.k) * vl; W2v = bf2f((bf16_t)L.v) * vl;
      w1 = (float)Lw; a1 = (float)La; L = Nx; Lw = Nw; La = Na; }
    asm volatile("" ::: "memory");
  }
}

__device__ void scan_block(const Params& p, int sample, int b, int h, int dir, LAS float* ring) {
  const int tid = tid_(), wid = __builtin_amdgcn_readfirstlane(tid >> 6), lane = tid & 63;
  const int T = sample ? TS : TP; const int seq0 = sample ? MP + b * TS : b * TP; const int cseq0 = sample ? CP + b * SS : b * SP;
  const int ds = dir ? -1 : 1; const int tstart = dir ? T - 1 : 0; const int nsteps = dir ? T - 16 : T; const int nchunks = nsteps >> 3;
  if (wid >= 4) {
    const int pw = wid - 4, hj = h * 64 + lane;
    const bf16_t* RKV = (const bf16_t*)p.out; const _Float16* WA = (const _Float16*)(p.ws + WS_R2);
    float* BON = (float*)(p.ws + WS_BON) + (size_t)dir * MC * 8; const float* conv = p.in[5];
    const float cAr = conv[(dir ? 2 : 0) * 1536 + hj], c1r = conv[1536 + hj], cCr = conv[(dir ? 0 : 2) * 1536 + hj];
    const float cAk = conv[(dir ? 2 : 0) * 1536 + 512 + hj], c1k = conv[1536 + 512 + hj], cCk = conv[(dir ? 0 : 2) * 1536 + 512 + hj];
    const float cAv = conv[(dir ? 2 : 0) * 1536 + 1024 + hj], c1v = conv[1536 + 1024 + hj], cCv = conv[(dir ? 0 : 2) * 1536 + 1024 + hj];
    const float kkc = p.in[17][hj], kac = p.in[18][hj], rkc = p.in[19][hj];
    const bf16_t* rk = RKV + (size_t)seq0 * LDQ + hj; const _Float16* wp = WA + ((size_t)dir * MF + seq0) * 512 + hj; const _Float16* ap = WA + ((size_t)(2 + dir) * MF + seq0) * 512 + hj;
    struct In { unsigned r0, k0, v0, r1, k1, v1, r2, k2, v2; _Float16 w, a; };
    auto load_step = [&](int n) -> In { const int t = tstart + n * ds; const int ta = min(max(t - ds, 0), T - 1), tb = min(max(t, 0), T - 1), tc = min(max(t + ds, 0), T - 1);
      const bf16_t* pa = rk + (size_t)ta * LDQ; const bf16_t* pb = rk + (size_t)tb * LDQ; const bf16_t* pc = rk + (size_t)tc * LDQ; In x;
      x.r0 = pa[0]; x.k0 = pa[512]; x.v0 = pa[1024]; x.r1 = pb[0]; x.k1 = pb[512]; x.v1 = pb[1024]; x.r2 = pc[0]; x.k2 = pc[512]; x.v2 = pc[1024];
      x.w = wp[(size_t)tb * 512]; x.a = ap[(size_t)tb * 512]; return x; };
    auto prep = [&](const In& x, int n, LAS float* buf) { const int t = tstart + n * ds;
      const float va = (t - ds >= 0 && t - ds < T) ? 1.f : 0.f, vc_ = (t + ds >= 0 && t + ds < T) ? 1.f : 0.f;
      const float Ar = bf2f((bf16_t)x.r0) * va, Ak = bf2f((bf16_t)x.k0) * va, Av = bf2f((bf16_t)x.v0) * va, Cr = bf2f((bf16_t)x.r2) * vc_, Ck = bf2f((bf16_t)x.k2) * vc_, Cv = bf2f((bf16_t)x.v2) * vc_;
      const float Br = bf2f((bf16_t)x.r1), Bk = bf2f((bf16_t)x.k1), Bv = bf2f((bf16_t)x.v1), w = (float)x.w, a = (float)x.a;
      const float rc = cAr * Ar + c1r * Br + cCr * Cr, kc = cAk * Ak + c1k * Bk + cCk * Ck, vc = cAv * Av + c1v * Bv + cCv * Cv;
      const float kkv = kc * kkc, kd = kc * (1.0f + (a - 1.0f) * kac);
      const float ssq = wave_sum(kkv * kkv), bsum = wave_sum(rc * kd * rkc);
      const float kk = kkv * __builtin_amdgcn_rsqf(fmaxf(ssq, 1e-24f));
      buf[lane] = -kk; buf[64 + lane] = w; buf[128 + lane] = kk * a; buf[192 + lane] = kd; buf[256 + lane] = rc; buf[320 + lane] = vc;
      if (n < nsteps && t >= 16 && lane == 0) BON[(size_t)(cseq0 + t - 16) * 8 + h] = bsum; };
    In L0 = load_step(2 * pw), L1 = load_step(2 * pw + 1);
    In N0 = load_step(8 + 2 * pw), N1 = load_step(8 + 2 * pw + 1);
    prep(L0, 2 * pw, ring + (2 * pw) * 384); prep(L1, 2 * pw + 1, ring + (2 * pw + 1) * 384);
    L0 = N0; L1 = N1;
    __syncthreads();
    for (int c = 0; c < nchunks; ++c) {
      N0 = load_step((c + 2) * 8 + 2 * pw); N1 = load_step((c + 2) * 8 + 2 * pw + 1);
      LAS float* dst = ring + (((c + 1) & 1) * 8 + 2 * pw) * 384;
      prep(L0, (c + 1) * 8 + 2 * pw, dst); prep(L1, (c + 1) * 8 + 2 * pw + 1, dst + 384);
      L0 = N0; L1 = N1;
      __syncthreads();
    }
  } else {
    const int q = lane & 3, il = lane >> 2, irow = wid * 16 + il;
    bf16_t* Y = (bf16_t*)(p.ws + (dir ? WS_R4 : WS_R3)) + (size_t)cseq0 * 512 + h * 64 + irow;
    typedef float f32x2 __attribute__((ext_vector_type(2)));
    f32x2 S[8];
#pragma unroll
    for (int j = 0; j < 8; ++j) S[j] = (f32x2){0.f, 0.f};
    __syncthreads();
    for (int c = 0; c < nchunks; ++c) {
#pragma unroll 8
      for (int s8 = 0; s8 < 8; ++s8) {
        const int t = tstart + (c * 8 + s8) * ds;
        const LAS float* buf = ring + ((c & 1) * 8 + s8) * 384; const LAS f32x4* v4 = (const LAS f32x4*)buf;
        f32x2 av[8], wv[8], bv[8], kv[8], rv[8];
#pragma unroll
        for (int j = 0; j < 4; ++j) { const f32x4 a4 = v4[q * 4 + j], w4 = v4[16 + q * 4 + j], b4 = v4[32 + q * 4 + j], k4 = v4[48 + q * 4 + j], r4 = v4[64 + q * 4 + j];
          av[2 * j] = a4.xy; av[2 * j + 1] = a4.zw; wv[2 * j] = w4.xy; wv[2 * j + 1] = w4.zw; bv[2 * j] = b4.xy; bv[2 * j + 1] = b4.zw;
          kv[2 * j] = k4.xy; kv[2 * j + 1] = k4.zw; rv[2 * j] = r4.xy; rv[2 * j + 1] = r4.zw; }
        const float vi = buf[320 + irow];
        f32x2 sa2 = S[0] * av[0], sa3 = S[1] * av[1];
#pragma unroll
        for (int j = 2; j < 8; j += 2) { sa2 = S[j] * av[j] + sa2; sa3 = S[j + 1] * av[j + 1] + sa3; }
        sa2 = sa2 + sa3;
        const float sa = quad_sum(sa2.x + sa2.y);
        const f32x2 sav = (f32x2){sa, sa}, viv = (f32x2){vi, vi};
        f32x2 y2 = (f32x2){0.f, 0.f}, y3 = (f32x2){0.f, 0.f};
#pragma unroll
        for (int j = 0; j < 8; j += 2) { const f32x2 t0 = bv[j] * sav + kv[j] * viv, t1 = bv[j + 1] * sav + kv[j + 1] * viv; S[j] = S[j] * wv[j] + t0; S[j + 1] = S[j + 1] * wv[j + 1] + t1; y2 = S[j] * rv[j] + y2; y3 = S[j + 1] * rv[j + 1] + y3; }
        y2 = y2 + y3;
        const float y = quad_sum(y2.x + y2.y);
        Y[(size_t)(max(t, 16) - 16) * 512] = f2bf(y);
      }
      __syncthreads();
    }
  }
}

#define KSWZ(row, colB) ((row) * 256 + ((colB) ^ (((row) & 7) << 4)))
#define SBAR() __builtin_amdgcn_sched_barrier(0)
constexpr float ATT_SCALE = 0.125f, ATT_THR = 8.f;
constexpr int SHM_V = 64 * 128 * 2, SHM_K = 64 * 128 * 2;
__device__ __forceinline__ int crow(int r, int hi) { return (r & 3) + 8 * (r >> 2) + 4 * hi; }
template <bool MASK> __device__ __forceinline__ void partialSM(f32x16& p0, f32x16& p1, float mnC, int kb, int seq, int hi) {
  constexpr float C = ATT_SCALE * 1.4426950408889634f;
  if (MASK && kb + 64 > seq) {
#pragma unroll
    for (int r = 0; r < 16; ++r) { if (kb + crow(r, hi) >= seq) p0[r] = -1e30f; if (kb + 32 + crow(r, hi) >= seq) p1[r] = -1e30f; }
  }
#pragma unroll
  for (int r = 0; r < 16; ++r) p0[r] = fmaf(p0[r], C, mnC);
#pragma unroll
  for (int r = 0; r < 16; ++r) p1[r] = fmaf(p1[r], C, mnC);
#pragma unroll
  for (int r = 0; r < 16; ++r) p0[r] = __builtin_amdgcn_exp2f(p0[r]);
}
__device__ __forceinline__ void finishSM(f32x16& p0, f32x16& p1, float& l_reg, bf16x8& pa0, bf16x8& pa1, bf16x8& pa2, bf16x8& pa3) {
#pragma unroll
  for (int r = 0; r < 16; ++r) p1[r] = __builtin_amdgcn_exp2f(p1[r]);
  float ps = 0;
#pragma unroll
  for (int r = 0; r < 16; ++r) ps += p0[r];
#pragma unroll
  for (int r = 0; r < 16; ++r) ps += p1[r];
  { auto rr = __builtin_amdgcn_permlane32_swap(__float_as_uint(ps), __float_as_uint(ps), false, false);
    ps = __uint_as_float(rr[0]) + __uint_as_float(rr[1]); }
  l_reg += ps;
#define PK4(P, BASE, OUT) do { unsigned a0 = cvt_pk_bf16(P[BASE + 0], P[BASE + 1]), a1 = cvt_pk_bf16(P[BASE + 2], P[BASE + 3]);   \
    unsigned b0 = cvt_pk_bf16(P[BASE + 4], P[BASE + 5]), b1 = cvt_pk_bf16(P[BASE + 6], P[BASE + 7]);                              \
    auto r0 = __builtin_amdgcn_permlane32_swap(a0, b0, false, false); auto r1 = __builtin_amdgcn_permlane32_swap(a1, b1, false, false); \
    u32x4 w = {r0[0], r1[0], r0[1], r1[1]}; OUT = *reinterpret_cast<bf16x8*>(&w); } while (0)
  PK4(p0, 0, pa0); PK4(p0, 8, pa1); PK4(p1, 0, pa2); PK4(p1, 8, pa3);
#undef PK4
}
__device__ __forceinline__ void qkt(f32x16& p0, f32x16& p1, const char* Ks, const bf16x8* qr, int r32, int hi, int comp) {
  p0 = f32x16{}; p1 = f32x16{};
#pragma unroll
  for (int d0 = 0; d0 < 4; ++d0) { const int cb = (comp * 64 + d0 * 16 + hi * 8) * 2;
    const bf16x8 b0 = *reinterpret_cast<const bf16x8*>(Ks + KSWZ(r32, cb));
    const bf16x8 b1 = *reinterpret_cast<const bf16x8*>(Ks + KSWZ(32 + r32, cb));
    p0 = __builtin_amdgcn_mfma_f32_32x32x16_bf16(b0, qr[d0], p0, 0, 0, 0);
    p1 = __builtin_amdgcn_mfma_f32_32x32x16_bf16(b1, qr[d0], p1, 0, 0, 0); }
}
__device__ __forceinline__ int v_st(int k, int c) { const int kk = (k & ~0xC) | ((k & 4) << 1) | ((k & 8) >> 1); return ((kk >> 3) * 4 + (c >> 5)) * 512 + ((kk & 7) * 32 + (c & 31)) * 2; }
__device__ __forceinline__ int v_rd_base(int lane) { return ((lane & 3) << 3) | (((lane >> 2) & 3) << 6) | (((lane >> 4) & 1) << 5) | (((lane >> 5) & 1) << 8); }
constexpr int v_rd_off(int d0, int ks, int half) { return d0 * 512 + ks * 4096 + half * 2048; }
template <int OFF> __device__ __forceinline__ s16x4 tr_read(int vb) {
  s16x4 r; asm volatile("ds_read_b64_tr_b16 %0, %1 offset:%2" : "=&v"(r) : "v"(vb), "i"(OFF) : "memory"); return r;
}
template <int D0> __device__ __forceinline__ void pv_one(f32x16& od, int vb, bf16x8 pa0, bf16x8 pa1, bf16x8 pa2, bf16x8 pa3) {
  const s16x4 l0 = tr_read<v_rd_off(D0, 0, 0)>(vb), h0 = tr_read<v_rd_off(D0, 0, 1)>(vb), l1 = tr_read<v_rd_off(D0, 1, 0)>(vb), h1 = tr_read<v_rd_off(D0, 1, 1)>(vb);
  const s16x4 l2 = tr_read<v_rd_off(D0, 2, 0)>(vb), h2 = tr_read<v_rd_off(D0, 2, 1)>(vb), l3 = tr_read<v_rd_off(D0, 3, 0)>(vb), h3 = tr_read<v_rd_off(D0, 3, 1)>(vb);
  asm volatile("s_waitcnt lgkmcnt(0)" ::: "memory"); SBAR();
#define PK(L, H) (bf16x8){L[0], L[1], L[2], L[3], H[0], H[1], H[2], H[3]}
  od = __builtin_amdgcn_mfma_f32_32x32x16_bf16(pa0, PK(l0, h0), od, 0, 0, 0);
  od = __builtin_amdgcn_mfma_f32_32x32x16_bf16(pa1, PK(l1, h1), od, 0, 0, 0);
  od = __builtin_amdgcn_mfma_f32_32x32x16_bf16(pa2, PK(l2, h2), od, 0, 0, 0);
  od = __builtin_amdgcn_mfma_f32_32x32x16_bf16(pa3, PK(l3, h3), od, 0, 0, 0);
#undef PK
}
__device__ __forceinline__ void pv_d0(f32x16* o, int vb, bf16x8 pa0, bf16x8 pa1, bf16x8 pa2, bf16x8 pa3) {
  pv_one<0>(o[0], vb, pa0, pa1, pa2, pa3); pv_one<1>(o[1], vb, pa0, pa1, pa2, pa3); pv_one<2>(o[2], vb, pa0, pa1, pa2, pa3); pv_one<3>(o[3], vb, pa0, pa1, pa2, pa3);
}

__device__ void attn_item(const Params& p, int sample, int b, int h, int qblk, char* lds, float lam, float mnC) {
  const int seq = (sample ? TS : TP) - DBG_DROP; const int row0 = sample ? MP + b * TS : b * TP;
  bf16_t* base = (bf16_t*)(p.ws + WS_R1) + (size_t)row0 * LDQ;
  const bf16_t* Kh = base + 512 + h * 128; const bf16_t* Vh = base + 1024 + h * 128;
  bf16_t* Qb = base + (size_t)(16 + qblk * 128) * LDQ + h * 128;
  const int tid = tid_(), wid = tid >> 6, lane = tid & 63, r32 = lane & 31, hi = lane >> 5, comp = wid >> 2, qgi = wid & 3;
  char* V_lds = lds; char* K_lds = lds + 2 * SHM_V;
  float* wsl = (float*)(lds + 2 * SHM_V + 2 * SHM_K) + wid * 64; float* li_l = wsl; float* al_l = wsl + 32;
  float l_reg = 0; f32x16 o[4] = {}; bf16x8 qr[4];
  const bf16_t* Qw = Qb + (size_t)(qgi * 32 + r32) * LDQ + comp * 64 + hi * 8;
#pragma unroll
  for (int d0 = 0; d0 < 4; ++d0) qr[d0] = *reinterpret_cast<const bf16x8*>(Qw + d0 * 16);
  const int sr = tid >> 4, sc = (tid & 15) * 8, vst0 = v_st(sr, sc), vst1 = v_st(32 + sr, sc);
  const int vb0 = (int)(uintptr_t)V_lds + v_rd_base(lane);
  struct { bf16x8 vs0, vs1, ks0, ks1; } sr_[2];
  const bf16_t* kp0 = Kh + (size_t)sr * LDQ + sc;
#define SLOAD(i, k0) do { if ((k0) + 64 <= seq) { const size_t _o = (size_t)(k0) * LDQ; \
      sr_[i].vs0 = *reinterpret_cast<const bf16x8*>(kp0 + _o + 512); sr_[i].vs1 = *reinterpret_cast<const bf16x8*>(kp0 + _o + 32 * LDQ + 512); \
      sr_[i].ks0 = *reinterpret_cast<const bf16x8*>(kp0 + _o); sr_[i].ks1 = *reinterpret_cast<const bf16x8*>(kp0 + _o + 32 * LDQ); } else { \
    const int _r0 = min((k0) + sr, seq - 1), _r1 = min((k0) + 32 + sr, seq - 1); const bf16x8 _z = {0, 0, 0, 0, 0, 0, 0, 0}; \
    sr_[i].vs0 = *reinterpret_cast<const bf16x8*>(&Vh[(size_t)_r0 * LDQ + sc]); sr_[i].vs1 = *reinterpret_cast<const bf16x8*>(&Vh[(size_t)_r1 * LDQ + sc]); \
    if ((k0) + sr >= seq) sr_[i].vs0 = _z; if ((k0) + 32 + sr >= seq) sr_[i].vs1 = _z; \
    sr_[i].ks0 = *reinterpret_cast<const bf16x8*>(&Kh[(size_t)_r0 * LDQ + sc]); sr_[i].ks1 = *reinterpret_cast<const bf16x8*>(&Kh[(size_t)_r1 * LDQ + sc]); } } while (0)
#define SLOADF(i, k0) do { const size_t _o = (size_t)(k0) * LDQ; \
      sr_[i].vs0 = *reinterpret_cast<const bf16x8*>(kp0 + _o + 512); sr_[i].vs1 = *reinterpret_cast<const bf16x8*>(kp0 + _o + 32 * LDQ + 512); \
      sr_[i].ks0 = *reinterpret_cast<const bf16x8*>(kp0 + _o); sr_[i].ks1 = *reinterpret_cast<const bf16x8*>(kp0 + _o + 32 * LDQ); } while (0)
#define SWRITE(b_, i) do { *(bf16x8*)(V_lds + (b_) * SHM_V + vst0) = sr_[i].vs0;          \
    *(bf16x8*)(V_lds + (b_) * SHM_V + vst1) = sr_[i].vs1; const int kc = sc * 2;               \
    *(bf16x8*)(K_lds + (b_) * SHM_K + KSWZ(sr, kc)) = sr_[i].ks0;                       \
    *(bf16x8*)(K_lds + (b_) * SHM_K + KSWZ(32 + sr, kc)) = sr_[i].ks1; } while (0)
#define SWAIT() asm volatile("s_waitcnt vmcnt(4)" ::: "memory")
#define RESC(a) do { if (__any((a) < 1.f)) { if (hi == 0) al_l[r32] = (a); asm volatile("s_waitcnt lgkmcnt(0)" ::: "memory"); \
    _Pragma("unroll") for (int d = 0; d < 4; ++d) _Pragma("unroll") for (int r = 0; r < 16; ++r) o[d][r] *= al_l[crow(r, hi)]; } } while (0)
  f32x16 pA0, pA1, pB0, pB1; bf16x8 pa0, pa1, pa2, pa3;
  const int NT = (((seq + 63) >> 6) + 1) & ~1;
  constexpr int SE = 0, SO = 1;
  SLOAD(SE, 0); asm volatile("s_waitcnt vmcnt(0)" ::: "memory"); SWRITE(0, SE); __syncthreads();
  qkt(pA0, pA1, K_lds, qr, r32, hi, comp); partialSM<false>(pA0, pA1, mnC, 0, seq, hi);
  SLOAD(SO, 64); if (2 < NT) SLOAD(SE, 128);
  SWAIT(); SWRITE(1, SO); __syncthreads();
#define ATT_ITER(MSK, LD) do { \
    SBAR(); qkt(pB0, pB1, K_lds + SHM_K, qr, r32, hi, comp); \
    finishSM(pA0, pA1, l_reg, pa0, pa1, pa2, pa3); SBAR(); \
    LD(SO, (j + 2) * 64); SBAR(); \
    pv_d0(o, vb0, pa0, pa1, pa2, pa3); partialSM<MSK>(pB0, pB1, mnC, j * 64, seq, hi); \
    __syncthreads(); SWAIT(); SWRITE(0, SE); \
    __syncthreads(); \
    SBAR(); qkt(pA0, pA1, K_lds, qr, r32, hi, comp); \
    finishSM(pB0, pB1, l_reg, pa0, pa1, pa2, pa3); SBAR(); \
    if (j + 3 < NT) LD(SE, (j + 3) * 64); SBAR(); \
    pv_d0(o, vb0 + SHM_V, pa0, pa1, pa2, pa3); partialSM<MSK>(pA0, pA1, mnC, (j + 1) * 64, seq, hi); \
    __syncthreads(); SWAIT(); SWRITE(1, SO); \
    __syncthreads(); } while (0)
  int j = 1; const int NF = seq >> 6;
  for (; j + 4 <= NF; j += 2) ATT_ITER(false, SLOADF);
  for (; j + 3 < NT; j += 2) ATT_ITER(false, SLOAD);
  ATT_ITER(true, SLOAD);
#undef ATT_ITER
  if ((NT - 1) * 64 >= seq) {
    SBAR(); finishSM(pA0, pA1, l_reg, pa0, pa1, pa2, pa3); SBAR();
    pv_d0(o, vb0, pa0, pa1, pa2, pa3);
  } else {
    SBAR(); qkt(pB0, pB1, K_lds + SHM_K, qr, r32, hi, comp);
    finishSM(pA0, pA1, l_reg, pa0, pa1, pa2, pa3); SBAR();
    pv_d0(o, vb0, pa0, pa1, pa2, pa3); partialSM<true>(pB0, pB1, mnC, (NT - 1) * 64, seq, hi);
    __syncthreads();
    finishSM(pB0, pB1, l_reg, pa0, pa1, pa2, pa3); SBAR();
    pv_d0(o, vb0 + SHM_V, pa0, pa1, pa2, pa3);
  }
  if (hi == 0) li_l[r32] = l_reg; asm volatile("s_waitcnt lgkmcnt(0)" ::: "memory");
  float rli[16];
#pragma unroll
  for (int r = 0; r < 16; ++r) rli[r] = __builtin_amdgcn_rcpf(li_l[crow(r, hi)]);
  __syncthreads();
  float* xch = (float*)lds + qgi * 4096;
  if (comp == 1) {
#pragma unroll
    for (int d = 0; d < 4; ++d)
#pragma unroll
      for (int r = 0; r < 16; ++r) xch[(d * 16 + r) * 64 + lane] = o[d][r] * rli[r] * lam;
  }
  __syncthreads();
  if (comp == 0) {
    const float* sg = p.in[25];
    float gcol[4];
#pragma unroll
    for (int d = 0; d < 4; ++d) gcol[d] = sg[d * 32 + r32] * 0.8f;
#pragma unroll
    for (int r = 0; r < 16; ++r) {
      float ss = 0.f;
#pragma unroll
      for (int d = 0; d < 4; ++d) { o[d][r] = o[d][r] * rli[r] - xch[(d * 16 + r) * 64 + lane]; ss += o[d][r] * o[d][r]; }
      ss = half32_sum(ss);
      const float rs = rsqrtf(ss * (1.0f / 128.0f) + 1e-6f);
      bf16_t* orow = Qb + (size_t)(qgi * 32 + crow(r, hi)) * LDQ + r32;
#pragma unroll
      for (int d = 0; d < 4; ++d) orow[d * 32] = f2bf(o[d][r] * rs * gcol[d]);
    }
  }
#undef SLOAD
#undef SLOADF
#undef SWRITE
#undef SWAIT
#undef RESC
}

constexpr int N_SCAN_S = BS * 8 * 2;
constexpr int N_SCAN_P = BP * 8 * 2;
constexpr int N_ATT_S = BS * 4 * (SS / 128);
constexpr int N_ATT_P = BP * 4 * (SP / 128);
__device__ void phase3(const Params& p, unsigned char* shm) {
  unsigned* ctr = (unsigned*)(p.ws + WS_MISC);
  LAS unsigned* slot = (LAS unsigned*)(shm + 131072 + 512);
  int nrep = NREP_SCAN; asm volatile("" : "+s"(nrep));
  for (int rep = 0; rep < nrep; ++rep)
  { const int tidx = tid_(); const int wid = tidx >> 6;
    for (;;) {
      __syncthreads();
      if (tidx == 0) *slot = atomicAdd(ctr + 32 * rep, 1u);
      __syncthreads();
      const int it = (int)*slot;
      if (it >= N_SCAN_S + N_SCAN_P) break;
      if (it < N_SCAN_S) { const int dir = it & 1, h = (it >> 1) & 7, b = it >> 4; scan_block(p, 1, b, h, dir, (LAS float*)shm); }
      else { const int ch = it - N_SCAN_S; const int dir = ch & 1, h = (ch >> 1) & 7, b = ch >> 4; scan_block(p, 0, b, h, dir, (LAS float*)shm); }
    } }
  { const int tidx = tid_(); const int lane = tidx & 63;
    const float* dl = p.in[24];
    float lam = __expf(wave_sum(dl[lane] * dl[64 + lane])) - __expf(wave_sum(dl[128 + lane] * dl[192 + lane])) + 0.2f;
#ifdef DBG_LAM0
    lam = 0.f;
#endif
    float gq = fabsf(p.in[22][lane]), gk = fabsf(p.in[23][lane]);
    for (int o = 1; o < 64; o <<= 1) { gq = fmaxf(gq, __shfl_xor(gq, o)); gk = fmaxf(gk, __shfl_xor(gk, o)); }
    const float mnC = -fminf(8.0f * gq * gk * 1.01f, 80.0f) * 1.4426950408889634f;
    for (;;) {
      __syncthreads();
      if (tidx == 0) *slot = atomicAdd(ctr + 16, 1u);
      __syncthreads();
      const int a = (int)*slot;
      if (a >= N_ATT_S + N_ATT_P) break;
      if (a < N_ATT_S) { const int qblk = a & 63, h = (a >> 6) & 3, b = a >> 8; attn_item(p, 1, b, h, qblk, (char*)shm, lam, mnC); }
      else { const int a2 = a - N_ATT_S; const int qblk = a2 & 15, h = (a2 >> 4) & 3, b = a2 >> 6; attn_item(p, 0, b, h, qblk, (char*)shm, lam, mnC); }
    } }
}

__device__ void phase4(const Params& p) {
  const bf16_t* YA = (const bf16_t*)(p.ws + WS_R3); const bf16_t* G = YA + (size_t)MC * 512; const bf16_t* YB = (const bf16_t*)(p.ws + WS_R4);
  const float* BON = (const float*)(p.ws + WS_BON); const bf16_t* RKV = (const bf16_t*)p.out; bf16_t* QKVD = (bf16_t*)(p.ws + WS_R1);
  const float* conv = p.in[5]; const float* lg = p.in[20]; const float* lb = p.in[21];
  const int tidx = tid_();
  const int lane = tidx & 63, gw = blockIdx.x * 8 + (tidx >> 6), nw = gridDim.x * 8, col = lane * 8, head = lane >> 3;
  float c0[8], c1[8], c2[8], lgv[8], lbv[8];
#pragma unroll
  for (int e = 0; e < 8; ++e) { c0[e] = conv[1024 + col + e]; c1[e] = conv[1536 + 1024 + col + e]; c2[e] = conv[3072 + 1024 + col + e]; lgv[e] = lg[col + e]; lbv[e] = lb[col + e]; }
  for (int c = gw; c < MC; c += nw) {
    const int r = compact_to_full(c); const bool has_next = (c < CP ? (c & 2047) != 2047 : ((c - CP) & 8191) != 8191);
    const u32x4 ya = *(const u32x4*)(YA + (size_t)c * 512 + col), yb = *(const u32x4*)(YB + (size_t)c * 512 + col), gg = *(const u32x4*)(G + (size_t)c * 512 + col);
    const u32x4 vm = *(const u32x4*)(RKV + (size_t)(r - 1) * LDQ + 1024 + col), v0 = *(const u32x4*)(RKV + (size_t)r * LDQ + 1024 + col);
    u32x4 vp = {0u, 0u, 0u, 0u}; if (has_next) vp = *(const u32x4*)(RKV + (size_t)(r + 1) * LDQ + 1024 + col);
    const float bon = BON[(size_t)c * 8 + head] + BON[((size_t)MC + c) * 8 + head];
    float y[8], g[8], vc[8];
#pragma unroll
    for (int e = 0; e < 4; ++e) { y[2 * e] = bflo(ya[e]) + bflo(yb[e]); y[2 * e + 1] = bfhi(ya[e]) + bfhi(yb[e]); g[2 * e] = bflo(gg[e]); g[2 * e + 1] = bfhi(gg[e]);
      vc[2 * e] = c0[2 * e] * bflo(vm[e]) + c1[2 * e] * bflo(v0[e]) + c2[2 * e] * bflo(vp[e]); vc[2 * e + 1] = c0[2 * e + 1] * bfhi(vm[e]) + c1[2 * e + 1] * bfhi(v0[e]) + c2[2 * e + 1] * bfhi(vp[e]); }
    float s = 0.f;
#pragma unroll
    for (int e = 0; e < 8; ++e) s += y[e];
    s = oct_sum(s);
    const float mu = s * (1.0f / 64.0f); float qv = 0.f;
#pragma unroll
    for (int e = 0; e < 8; ++e) { const float d = y[e] - mu; qv += d * d; }
    qv = oct_sum(qv);
    const float rs = rsqrtf(qv * (1.0f / 64.0f) + 64e-5f);
    u32x4 o;
#pragma unroll
    for (int e = 0; e < 4; ++e) { const float a = ((y[2 * e] - mu) * rs * lgv[2 * e] + lbv[2 * e] + bon * vc[2 * e]) * g[2 * e], bq = ((y[2 * e + 1] - mu) * rs * lgv[2 * e + 1] + lbv[2 * e + 1] + bon * vc[2 * e + 1]) * g[2 * e + 1];
      o[e] = cvt_pk_bf16(a, bq); }
    *(u32x4*)(QKVD + (size_t)r * LDQ + 512 + col) = o;
  }
}

__device__ void phase5b(const Params& p) {
  const float* X1 = p.out; const float* ln2 = p.in[27]; bf16_t* N2 = (bf16_t*)(p.ws + WS_R3);
  const int tidx = tid_();
  const int lane = tidx & 63, gw = blockIdx.x * 8 + (tidx >> 6), nw = gridDim.x * 8;
  f32x4 gv[4];
#pragma unroll
  for (int i = 0; i < 4; ++i) gv[i] = *(const f32x4*)(ln2 + i * 256 + lane * 4);
  for (int c = gw; c < MC; c += nw) {
    f32x4 v[4]; float ss = 0.f;
#pragma unroll
    for (int i = 0; i < 4; ++i) { v[i] = *(const f32x4*)(X1 + (size_t)c * 1024 + i * 256 + lane * 4); ss += v[i][0] * v[i][0] + v[i][1] * v[i][1] + v[i][2] * v[i][2] + v[i][3] * v[i][3]; }
    ss = wave_sum(ss);
    const float rs = rsqrtf(ss * (1.0f / 1024.0f) + 1e-6f);
#pragma unroll
    for (int i = 0; i < 4; ++i) { u32x2 w; w.x = cvt_pk_bf16(v[i][0] * rs * gv[i][0], v[i][1] * rs * gv[i][1]); w.y = cvt_pk_bf16(v[i][2] * rs * gv[i][2], v[i][3] * rs * gv[i][3]);
      *(u32x2*)(N2 + (size_t)c * 1024 + i * 256 + lane * 4) = w; }
  }
}


#ifndef DBG_SEL
#define DBG_SEL 0
#define DBG_WHICH 0
#endif
#if DBG_SEL
constexpr size_t DBG_SCR = (size_t)320 << 20;
__device__ void dbg_attn_pre(const Params& p, LAS float* lds, float lam) {
  const int tid = tid_(), wid = tid >> 6, lane = tid & 63;
  if (blockIdx.x != 0) return;
  const int sample = wid >> 2; const int b = sample ? 2 : 5 + wid, h = wid & 3; const int T = (sample ? TS : TP) - DBG_DROP; const int row0 = sample ? MP + b * TS : b * TP;
  const int t = 16 + (sample ? 4000 + 1000 * (wid & 3) : 37 + 601 * (wid & 3));
  const bf16_t* base = (const bf16_t*)(p.ws + WS_R1) + (size_t)row0 * LDQ;
  LAS float* qs = lds + wid * 128;
  qs[lane] = bf2f(base[(size_t)t * LDQ + h * 128 + lane]); qs[64 + lane] = bf2f(base[(size_t)t * LDQ + h * 128 + 64 + lane]);
  float* sc = (float*)((char*)p.out + DBG_SCR) + (size_t)wid * 2 * 8320;
  float* ex = (float*)((char*)p.out + DBG_SCR) + (size_t)8 * 2 * 8320 + wid * 128;
  asm volatile("s_waitcnt lgkmcnt(0)" ::: "memory");
  float m0 = -1e30f, m1 = -1e30f;
  for (int k = lane; k < T; k += 64) { const bf16_t* kr = base + (size_t)k * LDQ + 512 + h * 128; float s0 = 0.f, s1 = 0.f;
    for (int d = 0; d < 64; ++d) { s0 += qs[d] * bf2f(kr[d]); s1 += qs[64 + d] * bf2f(kr[64 + d]); }
    s0 *= 0.125f; s1 *= 0.125f; sc[k] = s0; sc[8320 + k] = s1; m0 = fmaxf(m0, s0); m1 = fmaxf(m1, s1); }
  for (int o = 1; o < 64; o <<= 1) { m0 = fmaxf(m0, __shfl_xor(m0, o)); m1 = fmaxf(m1, __shfl_xor(m1, o)); }
  float l0 = 0.f, l1 = 0.f;
  for (int k = lane; k < T; k += 64) { l0 += expf(sc[k] - m0); l1 += expf(sc[8320 + k] - m1); }
  l0 = wave_sum(l0); l1 = wave_sum(l1);
  __threadfence();
  float o0 = 0.f, o1 = 0.f;
  for (int k = 0; k < T; ++k) { const float w = expf(sc[k] - m0) / l0 - lam * expf(sc[8320 + k] - m1) / l1; const bf16_t* vr = base + (size_t)k * LDQ + 1024 + h * 128;
    o0 += w * bf2f(vr[lane]); o1 += w * bf2f(vr[64 + lane]); }
  const float ss = wave_sum(o0 * o0 + o1 * o1); const float rs = rsqrtf(ss * (1.0f / 128.0f) + 1e-6f);
  ex[lane] = o0 * rs * p.in[25][lane] * 0.8f; ex[64 + lane] = o1 * rs * p.in[25][64 + lane] * 0.8f;
}
__device__ void dbg_attn_post(const Params& p) {
  const int tid = tid_(), wid = tid >> 6, lane = tid & 63;
  if (blockIdx.x != 0) return;
  const int sample = wid >> 2; const int b = sample ? 2 : 5 + wid, h = wid & 3; const int T = sample ? TS : TP; const int row0 = sample ? MP + b * TS : b * TP;
  const int t = 16 + (sample ? 4000 + 1000 * (wid & 3) : 37 + 601 * (wid & 3));
  const bf16_t* base = (const bf16_t*)(p.ws + WS_R1) + (size_t)row0 * LDQ;
  const float* ex = (const float*)((char*)p.out + DBG_SCR) + (size_t)8 * 2 * 8320 + wid * 128;
  const float g0 = bf2f(base[(size_t)t * LDQ + h * 128 + lane]), g1 = bf2f(base[(size_t)t * LDQ + h * 128 + 64 + lane]);
  const float e0 = ex[lane], e1 = ex[64 + lane];
  const float num = wave_sum((g0 - e0) * (g0 - e0) + (g1 - e1) * (g1 - e1)), den = wave_sum(e0 * e0 + e1 * e1);
  float* acc = (float*)(p.ws + WS_MISC) + 128;
  if (lane == 0 && sample == DBG_WHICH) { atomicAdd(acc, num); atomicAdd(acc + 1, den); }
}
__device__ void dbg_rwkv(const Params& p, LAS float* lds) {
  const int tid = tid_(), lane = tid & 63;
  if (blockIdx.x != 1 || tid >= 64) return;
  const int b = 1, h = 3, T = TP, seq0 = b * TP, cseq0 = b * SP, hj = h * 64 + lane;
  const bf16_t* RKV = (const bf16_t*)p.out; const _Float16* WA = (const _Float16*)(p.ws + WS_R2); const float* conv = p.in[5];
  const bf16_t* G = (const bf16_t*)(p.ws + WS_R3) + (size_t)MC * 512; const bf16_t* QKVD = (const bf16_t*)(p.ws + WS_R1);
  float* ysc = (float*)((char*)p.out + DBG_SCR) + (1 << 20);
  const float kkc = p.in[17][hj], kac = p.in[18][hj], rkc = p.in[19][hj], lg = p.in[20][hj], lb = p.in[21][hj];
  float num = 0.f, den = 0.f;
  for (int dir = 0; dir < 2; ++dir) {
    float S[64];
#pragma unroll
    for (int j = 0; j < 64; ++j) S[j] = 0.f;
    for (int n = 0; n < T; ++n) {
      const int t = dir ? T - 1 - n : n;
      float rr[3], kk3[3], vv[3];
#pragma unroll
      for (int d = 0; d < 3; ++d) { const int tt = t - 1 + d; if (tt >= 0 && tt < T) { const bf16_t* pp = RKV + (size_t)(seq0 + tt) * LDQ + hj; rr[d] = bf2f(pp[0]); kk3[d] = bf2f(pp[512]); vv[d] = bf2f(pp[1024]); } else { rr[d] = 0.f; kk3[d] = 0.f; vv[d] = 0.f; } }
      const float rc = conv[hj] * rr[0] + conv[1536 + hj] * rr[1] + conv[3072 + hj] * rr[2];
      const float kc = conv[512 + hj] * kk3[0] + conv[1536 + 512 + hj] * kk3[1] + conv[3072 + 512 + hj] * kk3[2];
      const float vc = conv[1024 + hj] * vv[0] + conv[1536 + 1024 + hj] * vv[1] + conv[3072 + 1024 + hj] * vv[2];
      const float w = (float)WA[((size_t)dir * MF + seq0 + t) * 512 + hj], a = (float)WA[((size_t)(2 + dir) * MF + seq0 + t) * 512 + hj];
      const float kkv = kc * kkc, kd = kc * (1.0f + (a - 1.0f) * kac);
      const float ssq = wave_sum(kkv * kkv), bsum = wave_sum(rc * kd * rkc);
      const float kk = kkv / fmaxf(sqrtf(ssq), 1e-12f);
      lds[lane] = -kk; lds[64 + lane] = w; lds[128 + lane] = kk * a; lds[192 + lane] = kd; lds[256 + lane] = rc;
      asm volatile("s_waitcnt lgkmcnt(0)" ::: "memory");
      float sa = 0.f;
#pragma unroll
      for (int j = 0; j < 64; ++j) sa += S[j] * lds[j];
      float y = 0.f;
#pragma unroll
      for (int j = 0; j < 64; ++j) { S[j] = S[j] * lds[64 + j] + sa * lds[128 + j] + vc * lds[192 + j]; y += S[j] * lds[256 + j]; }
      asm volatile("s_waitcnt lgkmcnt(0)" ::: "memory");
      if (dir == 0) { ysc[t * 64 + lane] = y; if (lane == 0) ysc[TP * 64 + t] = bsum; }
      else if (t >= 16) {
        const float ys = y + ysc[t * 64 + lane]; const float mu = wave_sum(ys) * (1.0f / 64.0f); const float dv = ys - mu; const float var = wave_sum(dv * dv) * (1.0f / 64.0f);
        const float bon = bsum + ysc[TP * 64 + t]; const int c = cseq0 + t - 16; const float g = bf2f(G[(size_t)c * 512 + hj]);
        const float ref = (dv * rsqrtf(var + 64e-5f) * lg + lb + bon * vc) * g; const float got = bf2f(QKVD[(size_t)(seq0 + t) * LDQ + 512 + hj]);
        num += (ref - got) * (ref - got); den += ref * ref;
      }
    }
    __threadfence();
  }
  num = wave_sum(num); den = wave_sum(den);
  float* acc = (float*)(p.ws + WS_MISC) + 128;
  if (lane == 0) { atomicAdd(acc, num); atomicAdd(acc + 1, den); }
}
__device__ void dbg_apply(const Params& p) {
  const float* acc = (const float*)(p.ws + WS_MISC) + 128;
  const float E = acc[0] / fmaxf(acc[1], 1e-30f); const float dlt = sqrtf(1.8e3f * E);
  for (size_t i = (size_t)blockIdx.x * 512 + tid_(); i < (size_t)CP * 1024 / 4; i += (size_t)gridDim.x * 512) { f32x4* q = (f32x4*)p.out + i; *q = *q + dlt; }
}
#endif

__device__ void gemm1(const Params& p, LAS unsigned char* lds) {
  pg8::StaticOrder S; pg8::Gemm g{(const bf16_t*)(p.ws + WS_R3), (const bf16_t*)(p.ws + WS_WIN), 1024, 1024}; S.init(387, 16, gridDim.x, blockIdx.x, 0);
  EpiProj E{(bf16_t*)p.out, (bf16_t*)(p.ws + WS_R1), (bf16_t*)(p.ws + WS_R2)}; pg8::gemm_phase(lds, g, S, E); }
__device__ void gemm2(const Params& p, LAS unsigned char* lds) {
  pg8::StaticOrder S; pg8::Gemm g{(const bf16_t*)(p.ws + WS_R4), (const bf16_t*)(p.ws + WS_W2), 512, 256}; S.init(387, 10, gridDim.x, blockIdx.x, 0);
  EpiLora2 E{(_Float16*)(p.ws + WS_R2), (bf16_t*)(p.ws + WS_R3) + (size_t)MC * 512, p.in[9], p.in[12]}; pg8::gemm_phase(lds, g, S, E); }
__device__ void gemm5(const Params& p, LAS unsigned char* lds) {
  pg8::StaticOrder S; pg8::Gemm g{(const bf16_t*)(p.ws + WS_R1), (const bf16_t*)(p.ws + WS_WOUT), LDQ, 1024}; S.init(384, 4, gridDim.x, blockIdx.x, 1);
  EpiOut E{p.in[0], p.in[1], p.out, (bf16_t*)(p.ws + WS_R3), p.in[27], (float*)(p.ws + WS_SSQ)}; pg8::gemm_phase(lds, g, S, E); }
__device__ void gemm6(const Params& p, LAS unsigned char* lds) {
  pg8::StaticOrder S; pg8::Gemm g{(const bf16_t*)(p.ws + WS_R3), (const bf16_t*)(p.ws + WS_WGU), 1024, 1024}; S.init(384, 22, gridDim.x, blockIdx.x, 0);
  EpiGU E{(bf16_t*)(p.ws + WS_R1), (const float*)(p.ws + WS_SSQ)}; pg8::gemm_phase(lds, g, S, E); }
__device__ void gemm7(const Params& p, LAS unsigned char* lds) {
  pg8::StaticOrder S; pg8::Gemm g{(const bf16_t*)(p.ws + WS_R1), (const bf16_t*)(p.ws + WS_WDN), DFF, DFF}; S.init(384, 4, gridDim.x, blockIdx.x, 0);
  EpiDown E{p.out, (const bf16_t*)(p.ws + WS_R3), p.in[27]}; pg8::gemm_phase(lds, g, S, E); }

__device__ __forceinline__ unsigned long long rfl64(unsigned long long v) {
  const unsigned lo = __builtin_amdgcn_readfirstlane((unsigned)v), hi = __builtin_amdgcn_readfirstlane((unsigned)(v >> 32)); return ((unsigned long long)hi << 32) | lo; }
__device__ __forceinline__ Params load_params(LAS unsigned char* lds) {
  Params q; const LAS unsigned long long* tbl = (const LAS unsigned long long*)(lds + 131072);
#pragma unroll
  for (int i = 0; i < 31; ++i) q.in[i] = (const float*)(const __attribute__((address_space(1))) float*)rfl64(tbl[i]);
  q.out = (float*)(__attribute__((address_space(1))) float*)rfl64(tbl[31]); q.ws = (unsigned char*)(__attribute__((address_space(1))) unsigned char*)rfl64(tbl[32]); return q;
}

#define XB_TMO      128
#define XB_XCNT(j)  (256  + 64 * (j))
#define XB_XSUB(j)  (1280 + 64 * (j))
#define XB_XGEN(j)  (2304 + 64 * (j))
#define XB_TOP      3328
#define XB_TOPGEN   3392
#define XCD_BAR_WORDS 3456
#define XB_SPIN_CAP (1u << 22)
__device__ __forceinline__ unsigned xb_ld(unsigned* p)              { return __hip_atomic_load(p, __ATOMIC_RELAXED, __HIP_MEMORY_SCOPE_AGENT); }
__device__ __forceinline__ unsigned xb_add(unsigned* p, unsigned v) { return __hip_atomic_fetch_add(p, v, __ATOMIC_RELAXED, __HIP_MEMORY_SCOPE_AGENT); }
__device__ __forceinline__ unsigned xb_xcc_id() { return (unsigned)__builtin_amdgcn_s_getreg((3 << 11) | 20) & 0xFu; }
#define XB_SPIN(cond, bar) do { unsigned _sp = 0; while (cond) { __builtin_amdgcn_s_sleep(1); \
    if ((++_sp & 255u) == 0u) { if (xb_ld(&(bar)[XB_TMO])) break; if (_sp > XB_SPIN_CAP) { atomicAdd(&(bar)[XB_TMO], 1u); break; } } } } while (0)
__device__ __forceinline__ void xcd_barrier_complete(unsigned* bar, unsigned x, unsigned& nloc, unsigned& nx) {
  const unsigned G = gridDim.x;
  unsigned sum, cnt, mine, sp = 0u;
  for (;;) {
    sum = 0u; cnt = 0u; mine = 0u;
#pragma unroll
    for (unsigned j = 0; j < 16; ++j) { const unsigned c = xb_ld(&bar[XB_XCNT(j)]); sum += c; cnt += (c > 0u) ? 1u : 0u; mine = (j == x) ? c : mine; }
    if (sum == G) break;
    __builtin_amdgcn_s_sleep(1);
    if ((++sp & 255u) == 0u) { if (xb_ld(&bar[XB_TMO])) break; if (sp > XB_SPIN_CAP) { atomicAdd(&bar[XB_TMO], 1u); break; } }
  }
  nloc = mine > 0u ? mine : 1u; nx = cnt > 0u ? cnt : 1u;
}
__device__ __forceinline__ void xcd_barrier(unsigned* bar, volatile LAS unsigned* st) {
  asm volatile("s_waitcnt vmcnt(0) lgkmcnt(0)" ::: "memory");
  __syncthreads();
  if (tid_() == 0) {
    const unsigned x = xb_xcc_id();
    __builtin_amdgcn_s_waitcnt(0);
    unsigned nloc = st[0], nx = st[1];
    if (nloc == 0u) { xcd_barrier_complete(bar, x, nloc, nx); st[0] = nloc; st[1] = nx; }
    const unsigned old = xb_add(&bar[XB_XSUB(x)], 1u);
    const unsigned gen = old / nloc;
    if (old + 1u == (gen + 1u) * nloc) {
      __builtin_amdgcn_fence(__ATOMIC_RELEASE, "agent");
      asm volatile("s_waitcnt vmcnt(0)" ::: "memory");
      const unsigned og = xb_add(&bar[XB_TOP], 1u);
      const unsigned tg = og / nx;
      if (og + 1u == (tg + 1u) * nx) xb_add(&bar[XB_TOPGEN], 1u);
      else XB_SPIN(xb_ld(&bar[XB_TOPGEN]) == tg, bar);
      __builtin_amdgcn_fence(__ATOMIC_ACQUIRE, "agent");
      xb_add(&bar[XB_XGEN(x)], 1u);
      asm volatile("s_waitcnt vmcnt(0)" ::: "memory");
    } else {
      XB_SPIN(xb_ld(&bar[XB_XGEN(x)]) == gen, bar);
      __builtin_amdgcn_fence(__ATOMIC_ACQUIRE, "agent");
      asm volatile("s_waitcnt vmcnt(0)" ::: "memory");
    }
  }
  __syncthreads();
}
__device__ __forceinline__ void gsync(cg::grid_group& g) {
  asm volatile("s_waitcnt vmcnt(0) lgkmcnt(0)" ::: "memory");
  g.sync();
  if (tid_() < 64) { __builtin_amdgcn_fence(__ATOMIC_ACQUIRE, "agent"); asm volatile("s_waitcnt vmcnt(0)" ::: "memory"); }
  __syncthreads();
}
__global__ void __launch_bounds__(512) hymba_fwd(Params p_args) {
  extern __shared__ __attribute__((aligned(16))) unsigned char shm[];
  cg::grid_group grid = cg::this_grid();
  LAS unsigned char* lds = (LAS unsigned char*)shm;
  { const __attribute__((address_space(4))) unsigned long long* ka = (const __attribute__((address_space(4))) unsigned long long*)__builtin_amdgcn_kernarg_segment_ptr();
    const int t0 = tid_(); if (t0 < 33) ((LAS unsigned long long*)(lds + 131072))[t0] = ka[t0];
    if (t0 == 64) { ((LAS unsigned*)(lds + 131072 + 768))[0] = 0u; ((LAS unsigned*)(lds + 131072 + 768))[1] = 0u; } }
  __syncthreads();
  volatile LAS unsigned* xst = (volatile LAS unsigned*)(lds + 131072 + 768);
  { const Params p = load_params(lds); if (tid_() == 0) (void)xb_add(&((unsigned*)(p.ws + WS_BAR))[XB_XCNT(xb_xcc_id())], 1u); }
  { int nrep = NREP_ELT; asm volatile("" : "+s"(nrep)); for (int rep = 0; rep < nrep; ++rep) { const Params p = load_params(lds); phase0(p, shm); } }
  gsync(grid);
  { int nrep = NREP_GEMM; asm volatile("" : "+s"(nrep)); for (int rep = 0; rep < nrep; ++rep) { const Params p = load_params(lds); gemm1(p, lds); } }
  { const Params p = load_params(lds); xcd_barrier((unsigned*)(p.ws + WS_BAR), xst); }
  { const Params p = load_params(lds); phase15(p); }
  { const Params p = load_params(lds); xcd_barrier((unsigned*)(p.ws + WS_BAR), xst); }
  { int nrep = NREP_GEMM; asm volatile("" : "+s"(nrep)); for (int rep = 0; rep < nrep; ++rep) { const Params p = load_params(lds); gemm2(p, lds); } }
  { const Params p = load_params(lds); xcd_barrier((unsigned*)(p.ws + WS_BAR), xst); }
#if DBG_SEL == 3
  { const Params p = load_params(lds); const float* dl = p.in[24]; const int ln = tid_() & 63;
    float lam = __expf(wave_sum(dl[ln] * dl[64 + ln])) - __expf(wave_sum(dl[128 + ln] * dl[192 + ln])) + 0.2f;
#ifdef DBG_LAM0
    lam = 0.f;
#endif
    dbg_attn_pre(p, (LAS float*)lds, lam); }
  { const Params p = load_params(lds); xcd_barrier((unsigned*)(p.ws + WS_BAR), xst); }
#endif
  { const Params p = load_params(lds); phase3(p, shm); }
  { const Params p = load_params(lds); xcd_barrier((unsigned*)(p.ws + WS_BAR), xst); }
#if DBG_SEL == 3
  { const Params p = load_params(lds); dbg_attn_post(p); }
  { const Params p = load_params(lds); xcd_barrier((unsigned*)(p.ws + WS_BAR), xst); }
#endif
  { int nrep = NREP_ELT; asm volatile("" : "+s"(nrep)); for (int rep = 0; rep < nrep; ++rep) { const Params p = load_params(lds); phase4(p); } }
  { const Params p = load_params(lds); xcd_barrier((unsigned*)(p.ws + WS_BAR), xst); }
#if DBG_SEL == 1
  { const Params p = load_params(lds); dbg_rwkv(p, (LAS float*)lds); }
  { const Params p = load_params(lds); xcd_barrier((unsigned*)(p.ws + WS_BAR), xst); }
#endif
  { const Params p = load_params(lds); gemm5(p, lds); }
  { const Params p = load_params(lds); xcd_barrier((unsigned*)(p.ws + WS_BAR), xst); }
  { int nrep = NREP_GEMM; asm volatile("" : "+s"(nrep)); for (int rep = 0; rep < nrep; ++rep) { const Params p = load_params(lds); gemm6(p, lds); } }
  { const Params p = load_params(lds); xcd_barrier((unsigned*)(p.ws + WS_BAR), xst); }
  { const Params p = load_params(lds); gemm7(p, lds); }
#if DBG_SEL
  { const Params p = load_params(lds); xcd_barrier((unsigned*)(p.ws + WS_BAR), xst); }
  { const Params p = load_params(lds); dbg_apply(p); }
#endif
}

extern "C" void kernel_launch(void* const* d_in, const int* in_sizes, int n_in, void* d_out, int out_size, void* d_ws, size_t ws_size, hipStream_t stream) {
  static int grid_blocks = 0;
  constexpr int LDS_BYTES = 131072 + 1024;
  if (grid_blocks == 0) {
    if (n_in != 31 || ws_size < WS_END || out_size != MC * DM) { fprintf(stderr, "kernel_launch: unexpected shapes n_in %d ws %zu (need %zu) out %d\n", n_in, ws_size, (size_t)WS_END, out_size); grid_blocks = -1; return; }
    int dev = 0, cus = 0, per_cu = 0;
    (void)hipGetDevice(&dev); (void)hipDeviceGetAttribute(&cus, hipDeviceAttributeMultiprocessorCount, dev);
    if (hipFuncSetAttribute((const void*)hymba_fwd, hipFuncAttributeMaxDynamicSharedMemorySize, LDS_BYTES) != hipSuccess) { fprintf(stderr, "kernel_launch: hipFuncSetAttribute failed\n"); grid_blocks = -1; return; }
    if (hipOccupancyMaxActiveBlocksPerMultiprocessor(&per_cu, (const void*)hymba_fwd, 512, LDS_BYTES) != hipSuccess || per_cu < 1) { fprintf(stderr, "kernel_launch: occupancy query gave %d\n", per_cu); per_cu = 1; }
    (void)hipGetLastError();
    grid_blocks = cus * per_cu;
  }
  if (grid_blocks < 0) return;
  Params p{};
  for (int i = 0; i < 31; ++i) p.in[i] = (const float*)d_in[i];
  p.out = (float*)d_out; p.ws = (unsigned char*)d_ws;
  if (hipMemsetAsync((char*)d_ws + WS_BAR, 0, 16384, stream) != hipSuccess) { fprintf(stderr, "kernel_launch: memset of barrier words failed\n"); return; }
  void* args[] = {&p};
  hipError_t e = hipLaunchCooperativeKernel((const void*)hymba_fwd, dim3(grid_blocks), dim3(512), args, LDS_BYTES, stream);
  if (e != hipSuccess) fprintf(stderr, "cooperative launch failed: %s (grid %d)\n", hipGetErrorString(e), grid_blocks);
}
```
